# Optimizing an MI355X kernel written in HIP

```python
import jax, jax.numpy as jnp
from jax import lax
import numpy as np

D_MODEL = 1024
BATCH = 8
SEQ = 4096
DEPTH = 1

HEAD_DIM = D_MODEL // 16
RET_HEADS = 8
NSA_HEADS = 8
NSA_KV_GROUPS = 2
HEADS_PER_GROUP = NSA_HEADS // NSA_KV_GROUPS
RET_WIDTH = RET_HEADS * HEAD_DIM
NSA_WIDTH = NSA_HEADS * HEAD_DIM
MIX_WIDTH = RET_WIDTH + NSA_WIDTH
KV_WIDTH = NSA_KV_GROUPS * HEAD_DIM
RET_CHUNK = 128
RET_ROPE_BASE = 10000.0
NSA_ROPE_BASE = 500000.0
ROPE_DIM = HEAD_DIM // 4
CMP_BLOCK = 32
CMP_STRIDE = 16
CMP_HIDDEN = 256
SLC_BLOCK = 64
SLC_TOPK = 16
WINDOW = 512
NSA_QBLK = 64
NEG = -1e30
BIG = 1e9
EPS = 1e-6
SPLITS = (RET_WIDTH, RET_WIDTH, RET_WIDTH, RET_WIDTH, NSA_WIDTH, 6 * KV_WIDTH, 3 * NSA_HEADS, NSA_WIDTH)
PROJ_WIDTH = sum(SPLITS)

kernel_name = "hymba_retention_nsa_hybrid"


def rmsnorm(x, g):
    xf = x.astype(jnp.float32)
    y = xf * lax.rsqrt(jnp.mean(xf * xf, axis=-1, keepdims=True) + EPS) * g.astype(jnp.float32)
    return y.astype(x.dtype)


def rotary(x, pos, base, rot_dim):
    half = rot_dim // 2
    inv = jnp.power(base, -jnp.arange(half, dtype=jnp.float32) / half)
    ang = pos.astype(jnp.float32)[..., None] * inv
    cos = jnp.cos(ang)[:, :, None, :]
    sin = jnp.sin(ang)[:, :, None, :]
    x1 = x[..., :half].astype(jnp.float32)
    x2 = x[..., half:rot_dim].astype(jnp.float32)
    out = jnp.concatenate([(x1 * cos - x2 * sin).astype(x.dtype),
                           (x1 * sin + x2 * cos).astype(x.dtype),
                           x[..., rot_dim:]], axis=-1)
    return out


def masked_softmax(s, mask):
    s = jnp.where(mask, s.astype(jnp.float32), NEG)
    return jax.nn.softmax(s, axis=-1) * mask


def retention(q, k, v, pos):
    B, S, H, Dh = q.shape
    q = rotary(q, pos, RET_ROPE_BASE, Dh).astype(jnp.float32) * (Dh ** -0.5)
    k = rotary(k, pos, RET_ROPE_BASE, Dh).astype(jnp.float32)
    v = v.astype(jnp.float32)
    log_g = jnp.log1p(-jnp.power(2.0, -5.0 - jnp.arange(H, dtype=jnp.float32)))
    C = RET_CHUNK
    N = S // C
    qc = q.reshape(B, N, C, H, Dh)
    kc = k.reshape(B, N, C, H, Dh)
    vc = v.reshape(B, N, C, H, Dh)
    idx = jnp.arange(C, dtype=jnp.float32)
    diff = idx[:, None] - idx[None, :]
    decay = jnp.where(diff[None] >= 0, jnp.exp(jnp.maximum(diff, 0.0)[None] * log_g[:, None, None]), 0.0)
    scores = jnp.einsum('bnihd,bnjhd->bnhij', qc, kc) * decay
    inner = jnp.einsum('bnhij,bnjhe->bnihe', scores, vc)
    zeta = jnp.exp((C - 1 - idx)[None, :] * log_g[:, None])
    kv_chunk = jnp.einsum('bnjhd,hj,bnjhe->nbhde', kc, zeta, vc)
    chunk_decay = jnp.exp(C * log_g)[None, :, None, None]

    def step(R, kv):
        return R * chunk_decay + kv, R

    _, R_prev = lax.scan(step, jnp.zeros((B, H, Dh, Dh), jnp.float32), kv_chunk)
    xi = jnp.exp((idx + 1.0)[None, :] * log_g[:, None])
    cross = jnp.einsum('bnihd,nbhde,hi->bnihe', qc, R_prev, xi)
    o = (inner + cross).reshape(B, S, H, Dh)
    mu = jnp.mean(o, axis=-1, keepdims=True)
    var = jnp.mean(jnp.square(o - mu), axis=-1, keepdims=True)
    return (o - mu) * lax.rsqrt(var + 1e-5)


def compress(t, pe, w1, w2):
    B, S, G, Dh = t.shape
    Nc = (S - CMP_BLOCK) // CMP_STRIDE + 1
    cidx = np.arange(Nc)[:, None] * CMP_STRIDE + np.arange(CMP_BLOCK)[None, :]
    blocks = t[:, cidx] + pe[None, None, :, None, :].astype(t.dtype)
    flat = blocks.transpose(0, 1, 3, 2, 4).reshape(B, Nc, G, CMP_BLOCK * Dh)
    return jax.nn.silu(flat @ w1) @ w2


def nsa(q, kv_all, gate_logits, pos, pe_k, w1_k, w2_k, pe_v, w1_v, w2_v):
    B, S, Hq, Dh = q.shape
    G, hpg = NSA_KV_GROUPS, HEADS_PER_GROUP
    kv = kv_all.reshape(B, S, 6, G, Dh)
    k_c, v_c, k_s, v_s, k_w, v_w = [kv[:, :, i] for i in range(6)]
    q = rotary(q, pos, NSA_ROPE_BASE, ROPE_DIM) * (Dh ** -0.5)
    k_s = rotary(k_s, pos, NSA_ROPE_BASE, ROPE_DIM)
    k_w = rotary(k_w, pos, NSA_ROPE_BASE, ROPE_DIM)
    Nc = (S - CMP_BLOCK) // CMP_STRIDE + 1
    NS = S // SLC_BLOCK
    topk = min(SLC_TOPK, NS)
    cmp_start = np.arange(Nc) * CMP_STRIDE
    cmp_end = cmp_start + CMP_BLOCK - 1
    slc_start = np.arange(NS) * SLC_BLOCK
    overlap = jnp.asarray(((cmp_start[:, None] <= slc_start[None, :] + SLC_BLOCK - 1) &
                           (cmp_end[:, None] >= slc_start[None, :])).astype(np.float32))
    kc = rotary(compress(k_c, pe_k, w1_k, w2_k), pos[:, cmp_end], NSA_ROPE_BASE, ROPE_DIM)
    vc = compress(v_c, pe_v, w1_v, w2_v)
    kcT = kc.transpose(0, 2, 1, 3)
    vcT = vc.transpose(0, 2, 1, 3)
    qg = q.reshape(B, S, G, hpg, Dh).transpose(0, 2, 3, 1, 4)
    ks_blk = k_s.reshape(B, NS, SLC_BLOCK, G, Dh).transpose(0, 3, 1, 2, 4)
    vs_blk = v_s.reshape(B, NS, SLC_BLOCK, G, Dh).transpose(0, 3, 1, 2, 4)
    pad = ((0, 0), (0, 0), (WINDOW, 0), (0, 0))
    kw_pad = jnp.pad(k_w.transpose(0, 2, 1, 3), pad)
    vw_pad = jnp.pad(v_w.transpose(0, 2, 1, 3), pad)
    bidx = jnp.arange(B)[:, None, None, None]
    gidx = jnp.arange(G)[None, :, None, None]
    blk_ids = jnp.arange(NS)

    def block(bi):
        t0 = bi * NSA_QBLK
        qb = lax.dynamic_slice_in_dim(qg, t0, NSA_QBLK, axis=3)
        tq = t0 + jnp.arange(NSA_QBLK)
        s = jnp.einsum('bghqd,bgnd->bghqn', qb, kcT)
        p_cmp = masked_softmax(s, cmp_end[None, :] <= tq[:, None])
        o_cmp = jnp.einsum('bghqn,bgnd->bghqd', p_cmp, vcT.astype(jnp.float32))
        imp = jnp.einsum('bghqn,ns->bgqs', p_cmp, overlap)
        cur = tq // SLC_BLOCK
        valid = blk_ids[None, :] <= cur[:, None]
        forced = (blk_ids[None, :] == 0) | (blk_ids[None, :] == cur[:, None]) | (blk_ids[None, :] == cur[:, None] - 1)
        score = jnp.where(forced, BIG, jnp.where(valid, imp, NEG))
        top_val, top_idx = lax.top_k(score, topk)
        kg = ks_blk[bidx, gidx, top_idx]
        vg = vs_blk[bidx, gidx, top_idx]
        s = jnp.einsum('bghqd,bgqnkd->bghqnk', qb, kg).reshape(B, G, hpg, NSA_QBLK, topk * SLC_BLOCK)
        tok = top_idx[..., None] * SLC_BLOCK + jnp.arange(SLC_BLOCK)
        m = (tok <= tq[None, None, :, None, None]) & (top_val > 0.5 * NEG)[..., None]
        p_slc = masked_softmax(s, m.reshape(B, G, 1, NSA_QBLK, topk * SLC_BLOCK))
        o_slc = jnp.einsum('bghqm,bgqmd->bghqd', p_slc,
                           vg.reshape(B, G, NSA_QBLK, topk * SLC_BLOCK, Dh).astype(jnp.float32))
        kwb = lax.dynamic_slice_in_dim(kw_pad, t0, WINDOW + NSA_QBLK, axis=2)
        vwb = lax.dynamic_slice_in_dim(vw_pad, t0, WINDOW + NSA_QBLK, axis=2)
        kp = t0 - WINDOW + jnp.arange(WINDOW + NSA_QBLK)
        mw = (kp[None, :] >= 0) & (kp[None, :] <= tq[:, None]) & (tq[:, None] - kp[None, :] < WINDOW)
        s = jnp.einsum('bghqd,bgkd->bghqk', qb, kwb)
        p_win = masked_softmax(s, mw)
        o_win = jnp.einsum('bghqk,bgkd->bghqd', p_win, vwb.astype(jnp.float32))
        return o_cmp, o_slc, o_win

    o_cmp, o_slc, o_win = lax.map(block, jnp.arange(S // NSA_QBLK))
    to_bshd = lambda o: o.transpose(1, 0, 4, 2, 3, 5).reshape(B, S, Hq, Dh)
    g = jax.nn.sigmoid(gate_logits.astype(jnp.float32)).reshape(B, S, Hq, 3)
    o = g[..., 0:1] * to_bshd(o_cmp) + g[..., 1:2] * to_bshd(o_slc) + g[..., 2:3] * to_bshd(o_win)
    return o


def setup_inputs(seed: int = 0) -> dict:
    key = jax.random.key(seed)
    ks = jax.random.split(key, 20)
    f32 = jnp.float32
    nrm = lambda k, shape, scale: jax.random.normal(k, shape, f32) * scale
    x = jax.random.normal(ks[0], (BATCH, SEQ, D_MODEL), f32)
    c = jax.random.normal(ks[1], (BATCH, D_MODEL), f32)
    start = jax.random.randint(ks[2], (BATCH, 1), 0, 1024, dtype=jnp.int32)
    positions = start + jnp.arange(SEQ, dtype=jnp.int32)[None, :]
    return {
        "x": x,
        "c": c,
        "positions": positions,
        "w_ada": nrm(ks[3], (DEPTH, D_MODEL, 3 * D_MODEL), 0.5 * D_MODEL ** -0.5),
        "b_ada": nrm(ks[4], (DEPTH, 3 * D_MODEL), 0.02),
        "g_pre": 1.0 + nrm(ks[5], (DEPTH, D_MODEL), 0.05),
        "g_post": 1.0 + nrm(ks[6], (DEPTH, D_MODEL), 0.05),
        "w_in": nrm(ks[7], (DEPTH, D_MODEL, PROJ_WIDTH), D_MODEL ** -0.5),
        "w_out": nrm(ks[8], (DEPTH, MIX_WIDTH, D_MODEL), MIX_WIDTH ** -0.5),
        "cmp_pe_k": nrm(ks[9], (DEPTH, CMP_BLOCK, HEAD_DIM), 0.1),
        "cmp_w1_k": nrm(ks[10], (DEPTH, CMP_BLOCK * HEAD_DIM, CMP_HIDDEN), (CMP_BLOCK * HEAD_DIM) ** -0.5),
        "cmp_w2_k": nrm(ks[11], (DEPTH, CMP_HIDDEN, HEAD_DIM), CMP_HIDDEN ** -0.5),
        "cmp_pe_v": nrm(ks[12], (DEPTH, CMP_BLOCK, HEAD_DIM), 0.1),
        "cmp_w1_v": nrm(ks[13], (DEPTH, CMP_BLOCK * HEAD_DIM, CMP_HIDDEN), (CMP_BLOCK * HEAD_DIM) ** -0.5),
        "cmp_w2_v": nrm(ks[14], (DEPTH, CMP_HIDDEN, HEAD_DIM), CMP_HIDDEN ** -0.5),
    }


def reference(x, c, positions, w_ada, b_ada, g_pre, g_post, w_in, w_out,
              cmp_pe_k, cmp_w1_k, cmp_w2_k, cmp_pe_v, cmp_w1_v, cmp_w2_v):
    B, S, _ = x.shape
    offsets = np.cumsum(SPLITS)[:-1].tolist()
    for l in range(DEPTH):
        mod = jax.nn.silu(c) @ w_ada[l] + b_ada[l]
        shift, scale, gate = jnp.split(mod, 3, axis=-1)
        h = rmsnorm(x, g_pre[l]) * (1.0 + scale[:, None, :]) + shift[:, None, :]
        proj = h @ w_in[l]
        rq, rk, rv, rg, nq, nkv, ngl, ng = jnp.split(proj, offsets, axis=-1)
        hd = lambda t, H: t.reshape(B, S, H, HEAD_DIM)
        ret = retention(hd(rq, RET_HEADS), hd(rk, RET_HEADS), hd(rv, RET_HEADS), positions)
        ret = ret.reshape(B, S, RET_WIDTH) * jax.nn.silu(rg.astype(jnp.float32))
        att = nsa(hd(nq, NSA_HEADS), nkv, ngl, positions,
                  cmp_pe_k[l], cmp_w1_k[l], cmp_w2_k[l], cmp_pe_v[l], cmp_w1_v[l], cmp_w2_v[l])
        att = att.reshape(B, S, NSA_WIDTH) * jax.nn.silu(ng.astype(jnp.float32))
        mixed = jnp.concatenate([ret, att], axis=-1).astype(x.dtype)
        y = rmsnorm(mixed @ w_out[l], g_post[l])
        x = x + gate[:, None, :].astype(x.dtype) * y
    return x
```

```cpp
#include <hip/hip_runtime.h>
#include <hip/hip_cooperative_groups.h>
#include <cstdio>
#include <cstdint>
namespace cg = cooperative_groups;

#define LAS __attribute__((address_space(3)))
typedef unsigned short bf16_t;
typedef short bf16x8 __attribute__((ext_vector_type(8)));
typedef short s16x4 __attribute__((ext_vector_type(4)));
typedef float f32x2 __attribute__((ext_vector_type(2)));
typedef float f32x4 __attribute__((ext_vector_type(4)));
typedef float f32x16 __attribute__((ext_vector_type(16)));
typedef unsigned u32x2 __attribute__((ext_vector_type(2)));
typedef unsigned u32x4 __attribute__((ext_vector_type(4)));
typedef __bf16 bf16x2_t __attribute__((ext_vector_type(2)));

constexpr int NB = 8, SEQ = 4096, DM = 1024, MTOK = NB * SEQ;
constexpr int NPROJ = 4096;
constexpr int NTHREADS = 512, NWAVES = 8;
constexpr float LOG2E = 1.4426950408889634f;

constexpr size_t MiB = 1u << 20;
constexpr size_t WS_CTL = 0, CTL_BYTES = 1 * MiB;
constexpr size_t CTL_USED = 96 * 1024;
constexpr size_t WS_MOD = 1 * MiB;
constexpr int MOD_G = 5, MOD_GS = 8 * 3072;
constexpr size_t WS_BIAS1 = 1 * MiB + 512 * 1024;
constexpr size_t WS_ROWSS = 2 * MiB;
constexpr size_t WS_COSR = 4 * MiB, WS_SINR = 8 * MiB;
constexpr size_t WS_COSN = 12 * MiB, WS_SINN = 13 * MiB;
constexpr size_t WS_WIN_T = 16 * MiB;
constexpr size_t WS_WOUT_T = 24 * MiB;
constexpr size_t WS_W1K_T = 26 * MiB, WS_W1V_T = 27 * MiB;
constexpr size_t WS_W2K_T = 28 * MiB, WS_W2V_T = 28 * MiB + 64 * 1024;
constexpr size_t WS_KCMP = 29 * MiB, WS_VCMP = 29 * MiB + 512 * 1024;
constexpr size_t WS_HID = 30 * MiB;
constexpr size_t WS_NGL = 34 * MiB;
constexpr size_t WS_H = 64 * MiB;
constexpr size_t WS_RQ = 128 * MiB, WS_RK = 160 * MiB, WS_RV = 192 * MiB, WS_RG = 224 * MiB, WS_NQ = 256 * MiB, WS_NG = 288 * MiB;
constexpr size_t WS_KV6 = 320 * MiB;
constexpr size_t KV6_STRIDE = 8 * MiB;
constexpr size_t WS_OWIN = 368 * MiB;
constexpr size_t WS_Z = 400 * MiB;
constexpr size_t WS_END = 464 * MiB;
constexpr int CW_Q3 = 8192, CW_Q4 = 8192 + 512;

constexpr int LDS_BYTES = 147456;
constexpr int XO_P = 131072 + 4096, XO_S = XO_P + 4096, XO_FLAG = XO_S + 1024, XO_JUNK = 131072 + 10240;
constexpr size_t WS_GG = 1 * MiB + 768 * 1024;
constexpr int CW_KB = 3584;
constexpr int CW_PANEL = 12288;

struct Params {
  const float *x, *c; const int* pos; const float *w_ada, *b_ada, *g_pre, *g_post, *w_in, *w_out, *pe_k, *w1_k, *w2_k, *pe_v, *w1_v, *w2_v;
  float* out; unsigned char* ws;
  int ph_lo, ph_hi;
};

__device__ __forceinline__ unsigned pk2(float lo, float hi) { f32x2 v = {lo, hi}; bf16x2_t b = __builtin_convertvector(v, bf16x2_t); return __builtin_bit_cast(unsigned, b); }
__device__ __forceinline__ bf16_t f2bf(float f) { return (bf16_t)(pk2(f, 0.f) & 0xffffu); }
__device__ __forceinline__ float bf2f(unsigned short u) { return __uint_as_float(((unsigned)u) << 16); }
__device__ __forceinline__ float bflo(unsigned u) { return __uint_as_float(u << 16); }
__device__ __forceinline__ float bfhi(unsigned u) { return __uint_as_float(u & 0xffff0000u); }
__device__ __forceinline__ float fexp2(float x) { return __builtin_amdgcn_exp2f(x); }
__device__ __forceinline__ float siluf(float v) { return v * __builtin_amdgcn_rcpf(1.f + fexp2(-v * LOG2E)); }
__device__ __forceinline__ float sigmoidf(float v) { return __builtin_amdgcn_rcpf(1.f + fexp2(-v * LOG2E)); }
__device__ __forceinline__ float wave_sum(float v) {
#pragma unroll
  for (int o = 1; o < 64; o <<= 1) v += __shfl_xor(v, o);
  return v;
}
__device__ __forceinline__ s16x4 tr16(const LAS unsigned char* p) {
  typedef short v4i16_t __attribute__((ext_vector_type(4)));
  return __builtin_bit_cast(s16x4, __builtin_amdgcn_ds_read_tr16_b64_v4i16((LAS v4i16_t*)p));
}
__device__ __forceinline__ bf16x8 cat8(s16x4 a, s16x4 b) { return (bf16x8){a[0], a[1], a[2], a[3], b[0], b[1], b[2], b[3]}; }
#define MFMA16(a, b, c) __builtin_amdgcn_mfma_f32_16x16x32_bf16((a), (b), (c), 0, 0, 0)
#define MFMA32(a, b, c) __builtin_amdgcn_mfma_f32_32x32x16_bf16((a), (b), (c), 0, 0, 0)

__device__ __forceinline__ int retperm(int v) { const int j = v >> 3, i = v & 7; return (i < 4) ? 4 * j + i : 32 + 4 * j + (i - 4); }
__device__ __forceinline__ int nsaperm(int v) { const int j = v >> 3, i = v & 7; return (j < 2) ? ((i < 4) ? 4 * j + i : 8 + 4 * j + (i - 4)) : v; }
__device__ __forceinline__ int win_actual(int n) {
  const int pn = n >> 8, o = n & 255;
  if (pn < 8) { const int reg = pn >> 1, cr = (pn & 1) * 256 + o, head = cr >> 6, v = cr & 63; const int d = (pn < 4) ? retperm(v) : v; return reg * 512 + head * 64 + d; }
  if (pn < 10) { const int cr = (pn - 8) * 256 + o, head = cr >> 6, v = cr & 63; return 2048 + head * 64 + nsaperm(v); }
  if (pn < 13) { const int i6 = 2 * (pn - 10) + (o >> 7), w = o & 127, g = w >> 6, v = w & 63; const int d = (i6 == 2 || i6 == 4) ? nsaperm(v) : v; return 2560 + i6 * 128 + g * 64 + d; }
  if (pn < 15) return 3352 + (pn - 13) * 256 + o;
  return (o < 24) ? 3328 + o : -1;
}

#ifndef WGM_P2
#define WGM_P2 4
#endif
#ifndef WGM_P5
#define WGM_P5 8
#endif
namespace pg8 {
constexpr int BM = 256, BK = 64, HALF = 128, HTB = HALF * BK * 2, STAGE_BYTES = 8 * HTB, NXCD = 8;
__host__ __device__ __forceinline__ int lds_byte(int r, int c) { const int st = (r >> 4) * 2 + (c >> 5), rr = r & 15, cc = c & 31, ob = rr * 64 + cc * 2; return st * 1024 + (ob ^ (((ob >> 9) & 1) << 5)); }
__host__ __device__ __forceinline__ void stage_rc(int b, int& R, int& C) { const int st = b / 1024, sb = b % 1024, swz = sb ^ (((sb >> 9) & 1) << 5); R = (st >> 1) * 16 + swz / 64; C = (st & 1) * 32 + (swz % 64) / 2; }
__host__ __device__ __forceinline__ int perm32(int rho) { const int n = rho >> 4, i = rho & 15; return 8 * (i >> 2) + 4 * n + (i & 3); }
struct Unit { int pm, pn; };
struct Gemm { const bf16_t* A; const bf16_t* Bt; int M, N, K, lda, kstepA, ldb; };
struct StaticOrder {
  int nM, nN, nwg, G, c, WGM;
  __device__ void init(int M, int N, int G_, int c_, int wgm) { nM = M / BM; nN = N / BM; nwg = nM * nN; G = G_; c = c_; WGM = wgm; }
  __device__ bool next(int i, Unit& u) const {
    const long L = (long)i * G + c; if (L >= nwg) return false;
    int wgid = (int)L; { const int q = nwg / NXCD, r = nwg % NXCD, xcd = wgid % NXCD, off = wgid / NXCD; wgid = (xcd < r ? xcd * (q + 1) : r * (q + 1) + (xcd - r) * q) + off; }
    const int nig = WGM * nN, gid = wgid / nig, fm = gid * WGM, gsz = (nM - fm) < WGM ? (nM - fm) : WGM;
    u.pm = fm + ((wgid % nig) % gsz); u.pn = (wgid % nig) / gsz; return true;
  }
};
struct OneUnit { int valid; __device__ bool next(int i, Unit& u) const { if (i > 0 || !valid) return false; u.pm = 0; u.pn = 0; return true; } };

template <class Epi, class Sched>
__device__ __forceinline__ void gemm_phase(LAS unsigned char* lds, const Gemm g, const Sched& S, const Epi& E) {
  int tid_ = threadIdx.x; asm volatile("" : "+v"(tid_));
  const int tid = tid_, wid = __builtin_amdgcn_readfirstlane(tid >> 6), lane = tid & 63, wr = wid >> 2, wc = wid & 3, fr = lane & 15, fq = lane >> 4;
  const int K = g.K, nt = K / BK;
  unsigned voffA[2], voffB[2];
#pragma unroll
  for (int i = 0; i < 2; ++i) { int R, C; stage_rc(tid * 16 + i * 8192, R, C); const int Rb = (R & ~31) + perm32(R & 31);
    voffA[i] = (unsigned)(R * g.lda + C) * 2u; voffB[i] = (unsigned)(Rb * g.ldb + C) * 2u; }
  const size_t kstepB = (size_t)(BK * 2), kstepA = (size_t)g.kstepA;
  const size_t hstepB = (size_t)HALF * g.ldb * 2, hstepA = (size_t)HALF * g.lda * 2;
  const size_t tstepB = 2 * hstepB, tstepA = 2 * hstepA;
  const unsigned ldsw = (unsigned)wid * 1024u;
  const int aoff = lds_byte(wr * 64 + fr, fq * 8), boff = lds_byte(wc * 32 + fr, fq * 8);
#define PG8_SA(b, h) (((b) * 2 + (h)) * HTB)
#define PG8_SB(b, h) ((4 + (b) * 2 + (h)) * HTB)
#define PG8_STAGE(bufoff, gbase, voff) do { _Pragma("unroll") for (int _i = 0; _i < 2; ++_i) \
    __builtin_amdgcn_global_load_lds((const unsigned*)((const char*)(gbase) + (voff)[_i]), (LAS unsigned*)(lds + (bufoff) + ldsw + _i * 8192), 16, 0, 0); } while (0)
#define PG8_LDA(dst, b, h) do { _Pragma("unroll") for (int m = 0; m < 4; ++m) _Pragma("unroll") for (int k = 0; k < 2; ++k) dst[m][k] = *(const LAS bf16x8*)(lds + PG8_SA(b, h) + aoff + m * 2048 + k * 1024); } while (0)
#define PG8_LDB(dst, b, h) do { _Pragma("unroll") for (int n = 0; n < 2; ++n) _Pragma("unroll") for (int k = 0; k < 2; ++k) dst[n][k] = *(const LAS bf16x8*)(lds + PG8_SB(b, h) + boff + n * 2048 + k * 1024); } while (0)
#define PG8_MMA(ai, bj, At, Bt) do { __builtin_amdgcn_s_setprio(1); _Pragma("unroll") for (int m = 0; m < 4; ++m) _Pragma("unroll") for (int n = 0; n < 2; ++n) _Pragma("unroll") for (int k = 0; k < 2; ++k) \
    acc[ai][bj][m][n] = __builtin_amdgcn_mfma_f32_16x16x32_bf16(Bt[n][k], At[m][k], acc[ai][bj][m][n], 0, 0, 0); __builtin_amdgcn_s_setprio(0); } while (0)
#define PG8_WAIT_V(n) asm volatile("s_waitcnt vmcnt(" #n ")" ::: "memory")
#define PG8_WAIT_L(n) asm volatile("s_waitcnt lgkmcnt(" #n ")" ::: "memory")
#define PG8_BAR __builtin_amdgcn_s_barrier()
#define PG8_SCHED __builtin_amdgcn_sched_barrier(0)
  Unit cur, nxt; int ui = 0;
  if (!S.next(0, cur)) return;
  f32x4 acc[2][2][4][2];
#pragma unroll
  for (int a = 0; a < 2; ++a)
#pragma unroll
    for (int b = 0; b < 2; ++b)
#pragma unroll
      for (int m = 0; m < 4; ++m)
#pragma unroll
        for (int n = 0; n < 2; ++n) acc[a][b][m][n] = (f32x4){0.f, 0.f, 0.f, 0.f};
  bf16x8 At[4][2], B0[2][2], B1[2][2];
  const char* cA = (const char*)g.A + (size_t)cur.pm * tstepA; const char* cB = (const char*)g.Bt + (size_t)cur.pn * tstepB;
  E.prefetch(cur, tid, lds);
  PG8_STAGE(PG8_SB(0, 0), cB, voffB); PG8_STAGE(PG8_SB(0, 1), cB + hstepB, voffB); PG8_STAGE(PG8_SA(0, 0), cA, voffA); PG8_STAGE(PG8_SA(0, 1), cA + hstepA, voffA);
  if (wr == 1) PG8_BAR;
  PG8_WAIT_V(2); PG8_BAR;
  PG8_STAGE(PG8_SB(1, 0), cB + kstepB, voffB); PG8_STAGE(PG8_SA(1, 0), cA + kstepA, voffA); PG8_STAGE(PG8_SB(1, 1), cB + hstepB + kstepB, voffB);
  PG8_WAIT_V(6); PG8_BAR;
  for (;;) {
    const bool has_next = S.next(ui + 1, nxt);
    const char* nA = has_next ? (const char*)g.A + (size_t)nxt.pm * tstepA : cA; const char* nB = has_next ? (const char*)g.Bt + (size_t)nxt.pn * tstepB : cB;
    for (int t = 0; t < nt; t += 2) {
      const bool last = (t == nt - 2);
      const char* a1 = cA + (size_t)(t + 1) * kstepA;
      const char* a2 = last ? nA : cA + (size_t)(t + 2) * kstepA; const char* b2 = last ? nB : cB + (size_t)(t + 2) * kstepB;
      const char* a3 = a2 + kstepA; const char* b3 = b2 + kstepB;
      PG8_LDB(B0, 0, 0); PG8_LDB(B1, 0, 1); PG8_SCHED; PG8_LDA(At, 0, 0); PG8_STAGE(PG8_SA(1, 1), a1 + hstepA, voffA);
      PG8_WAIT_V(8); PG8_WAIT_L(0); PG8_BAR; PG8_MMA(0, 0, At, B0); PG8_MMA(0, 1, At, B1); PG8_BAR; PG8_SCHED;
      PG8_LDA(At, 0, 1); PG8_STAGE(PG8_SB(0, 0), b2, voffB); PG8_STAGE(PG8_SB(0, 1), b2 + hstepB, voffB); PG8_STAGE(PG8_SA(0, 0), a2, voffA);
      PG8_WAIT_V(8); PG8_WAIT_L(0); PG8_BAR; PG8_MMA(1, 0, At, B0); PG8_MMA(1, 1, At, B1); PG8_BAR; PG8_SCHED;
      PG8_LDB(B0, 1, 0); PG8_LDB(B1, 1, 1); PG8_SCHED; PG8_LDA(At, 1, 0); PG8_STAGE(PG8_SA(0, 1), a2 + hstepA, voffA);
      PG8_WAIT_V(8); PG8_WAIT_L(0); PG8_BAR; PG8_MMA(0, 0, At, B0); PG8_MMA(0, 1, At, B1); PG8_BAR; PG8_SCHED;
      PG8_LDA(At, 1, 1); PG8_STAGE(PG8_SB(1, 0), b3, voffB); PG8_STAGE(PG8_SB(1, 1), b3 + hstepB, voffB); PG8_STAGE(PG8_SA(1, 0), a3, voffA);
      PG8_WAIT_V(8); PG8_WAIT_L(0); PG8_BAR; PG8_MMA(1, 0, At, B0); PG8_MMA(1, 1, At, B1); PG8_BAR; PG8_SCHED;
    }
    if (wr == 0) PG8_BAR;
    E(acc, cur, wr, wc, fr, fq);
    if (!has_next) break;
    E.prefetch(nxt, tid, lds);
#pragma unroll
    for (int a = 0; a < 2; ++a)
#pragma unroll
      for (int b = 0; b < 2; ++b)
#pragma unroll
        for (int m = 0; m < 4; ++m)
#pragma unroll
          for (int n = 0; n < 2; ++n) acc[a][b][m][n] = (f32x4){0.f, 0.f, 0.f, 0.f};
    cur = nxt; cA = nA; cB = nB; ++ui;
    if (wr == 1) PG8_BAR;
  }
  PG8_WAIT_V(0);
  PG8_BAR;
#undef PG8_SA
#undef PG8_SB
#undef PG8_STAGE
#undef PG8_LDA
#undef PG8_LDB
#undef PG8_MMA
#undef PG8_WAIT_V
#undef PG8_WAIT_L
#undef PG8_BAR
#undef PG8_SCHED
}
}

struct EpiProj {
  __device__ __forceinline__ void prefetch(const pg8::Unit&, int, LAS unsigned char*) const {}
  unsigned char* ws;
  template <int M0, int M1, bool TRK>
  __device__ __forceinline__ void body(const f32x4 (&acc)[2][2][4][2], bf16_t* base0, bf16_t* base1, int ld, float sc, bool st0, bool st1, int row0, int cw, int j, unsigned* kbw) const {
    const float* cosr = (const float*)(ws + WS_COSR); const float* sinr = (const float*)(ws + WS_SINR);
    const float* cosn = (const float*)(ws + WS_COSN); const float* sinn = (const float*)(ws + WS_SINN);
    float kmx = 0.f;
#pragma unroll
    for (int ai = 0; ai < 2; ++ai)
#pragma unroll
      for (int m = 0; m < 4; ++m) {
        const int row = row0 + ai * 128 + m * 16;
        f32x4 cs = {1.f, 1.f, 1.f, 1.f}, sn = {0.f, 0.f, 0.f, 0.f};
        if (M0 == 1) { cs = *(const f32x4*)(cosr + (size_t)row * 32 + 4 * j); sn = *(const f32x4*)(sinr + (size_t)row * 32 + 4 * j); }
        else if (M0 == 2) { if (j < 2) { cs = *(const f32x4*)(cosn + (size_t)row * 8 + 4 * j); sn = *(const f32x4*)(sinn + (size_t)row * 8 + 4 * j); } }
#pragma unroll
        for (int bj = 0; bj < 2; ++bj) {
          const int mode = bj ? M1 : M0;
          f32x4 v0 = acc[ai][bj][m][0], v1 = acc[ai][bj][m][1];
          if (mode != 0) { const f32x4 a = v0 * cs - v1 * sn, b = v0 * sn + v1 * cs; v0 = a; v1 = b; }
          v0 = v0 * sc; v1 = v1 * sc;
          u32x4 w; w.x = pk2(v0[0], v0[1]); w.y = pk2(v0[2], v0[3]); w.z = pk2(v1[0], v1[1]); w.w = pk2(v1[2], v1[3]);
          bf16_t* bp = bj ? base1 : base0;
          if (bj ? st1 : st0) *(u32x4*)(bp + (size_t)row * ld + cw) = w;
          if (TRK && bj == 0) {
            float ss = ((v0[0] * v0[0] + v0[1] * v0[1]) + (v0[2] * v0[2] + v0[3] * v0[3])) + ((v1[0] * v1[0] + v1[1] * v1[1]) + (v1[2] * v1[2] + v1[3] * v1[3]));
            ss += __shfl_xor(ss, 16); ss += __shfl_xor(ss, 32);
            kmx = fmaxf(kmx, ss);
          }
        }
      }
    if (TRK) {
#pragma unroll
      for (int o = 1; o < 16; o <<= 1) kmx = fmaxf(kmx, __shfl_xor(kmx, o));
      if ((threadIdx.x & 63) == 0) atomicMax(kbw, __float_as_uint(kmx));
    }
  }
  __device__ __forceinline__ void operator()(const f32x4 (&acc)[2][2][4][2], const pg8::Unit& u, int wr, int wc, int fr, int fq) const {
    const int pn = u.pn;
    const int row0 = u.pm * 256 + wr * 64 + fr;
    const int cw = wc * 32 + 8 * fq;
    const int j = 4 * (wc & 1) + fq;
    if (pn < 4) { bf16_t* bp = (bf16_t*)(ws + WS_RQ + (size_t)(pn >> 1) * 32 * MiB) + (pn & 1) * 256; body<1, 1, false>(acc, bp, bp + 128, 512, (pn < 2) ? 0.125f : 1.f, true, true, row0, cw, j, nullptr); }
    else if (pn < 8) { bf16_t* bp = (bf16_t*)(ws + WS_RQ + (size_t)(pn >> 1) * 32 * MiB) + (pn & 1) * 256; body<0, 0, false>(acc, bp, bp + 128, 512, 1.f, true, true, row0, cw, j, nullptr); }
    else if (pn < 10) { bf16_t* bp = (bf16_t*)(ws + WS_NQ) + (pn - 8) * 256; body<2, 2, false>(acc, bp, bp + 128, 512, 0.125f * LOG2E, true, true, row0, cw, j, nullptr); }
    else if (pn < 13) {
      const int i6 = 2 * (pn - 10); bf16_t* b0 = (bf16_t*)(ws + WS_KV6 + (size_t)i6 * KV6_STRIDE); bf16_t* b1 = (bf16_t*)(ws + WS_KV6 + (size_t)(i6 + 1) * KV6_STRIDE);
      if (pn == 10) body<0, 0, false>(acc, b0, b1, 128, 1.f, true, true, row0, cw, j, nullptr);
      else body<2, 0, true>(acc, b0, b1, 128, 1.f, true, true, row0, cw, j, (unsigned*)(ws + WS_CTL) + CW_KB + (((pn - 11) * 16 + (u.pm >> 4) * 2 + (wc >> 1)) * 2 + (wc & 1)));
    }
    else if (pn < 15) { bf16_t* bp = (bf16_t*)(ws + WS_NG) + (pn - 13) * 256; body<0, 0, false>(acc, bp, bp + 128, 512, 1.f, true, true, row0, cw, j, nullptr); }
    else { bf16_t* bp = (bf16_t*)(ws + WS_NGL); body<0, 0, false>(acc, bp, bp, 32, 1.f, (wc == 0 && fq < 4), false, row0, cw, j, nullptr); }
  }
};
struct EpiZ {
  __device__ __forceinline__ void prefetch(const pg8::Unit&, int, LAS unsigned char*) const {}
  bf16_t* Z; float* rowss;
  __device__ __forceinline__ void operator()(const f32x4 (&acc)[2][2][4][2], const pg8::Unit& u, int wr, int wc, int fr, int fq) const {
    const int row0 = u.pm * 256 + wr * 64 + fr, col0 = u.pn * 256 + wc * 32 + 8 * fq;
#pragma unroll
    for (int ai = 0; ai < 2; ++ai)
#pragma unroll
      for (int m = 0; m < 4; ++m) {
        const int row = row0 + ai * 128 + m * 16; float ss = 0.f;
#pragma unroll
        for (int bj = 0; bj < 2; ++bj) {
          const f32x4 v0 = acc[ai][bj][m][0], v1 = acc[ai][bj][m][1];
          ss += (v0[0] * v0[0] + v0[1] * v0[1]) + (v0[2] * v0[2] + v0[3] * v0[3]) + (v1[0] * v1[0] + v1[1] * v1[1]) + (v1[2] * v1[2] + v1[3] * v1[3]);
          u32x4 w; w.x = pk2(v0[0], v0[1]); w.y = pk2(v0[2], v0[3]); w.z = pk2(v1[0], v1[1]); w.w = pk2(v1[2], v1[3]);
          *(u32x4*)(Z + (size_t)row * DM + col0 + bj * 128) = w;
        }
      }
  }
};
#ifndef XNE
#define XNE 8
#endif
struct EpiOut {
  __device__ __forceinline__ void prefetch(const pg8::Unit& u, int tid, LAS unsigned char* l) const {
    const int wv = __builtin_amdgcn_readfirstlane(tid >> 6);
#pragma unroll
    for (int k = 0; k < 4; ++k) { const int L = tid + 512 * k; const float* a = x + ((size_t)u.pm * 256 + (L >> 3)) * DM + u.pn * 256 + (L & 7) * 32;
      __builtin_amdgcn_global_load_lds((const unsigned*)a, (LAS unsigned*)(l + XO_JUNK + wv * 256), 4, 0, 0); }
  }
  const float* x; float* out; const float* gg; float* xbuf; unsigned* cnt; LAS unsigned char* lds;
  __device__ __forceinline__ void operator()(const f32x4 (&acc)[2][2][4][2], const pg8::Unit& u, int wr, int wc, int fr, int fq) const {
    const int tid = threadIdx.x, lane = tid & 63, wid = tid >> 6;
    LAS float* P = (LAS float*)(lds + XO_P); LAS float* S = (LAS float*)(lds + XO_S); LAS unsigned* flag = (LAS unsigned*)(lds + XO_FLAG);
    u32x2 zp[2][2][4][2];
#pragma unroll
    for (int ai = 0; ai < 2; ++ai)
#pragma unroll
      for (int m = 0; m < 4; ++m) {
        float ss = 0.f;
#pragma unroll
        for (int bj = 0; bj < 2; ++bj) { const f32x4 v0 = acc[ai][bj][m][0], v1 = acc[ai][bj][m][1];
          ss += (v0[0] * v0[0] + v0[1] * v0[1]) + (v0[2] * v0[2] + v0[3] * v0[3]) + (v1[0] * v1[0] + v1[1] * v1[1]) + (v1[2] * v1[2] + v1[3] * v1[3]);
          zp[ai][bj][m][0] = (u32x2){pk2(v0[0], v0[1]), pk2(v0[2], v0[3])}; zp[ai][bj][m][1] = (u32x2){pk2(v1[0], v1[1]), pk2(v1[2], v1[3])};
          asm volatile("" : "+v"(zp[ai][bj][m][0]), "+v"(zp[ai][bj][m][1])); }
        ss += __shfl_xor(ss, 16); ss += __shfl_xor(ss, 32);
        if (fq == 0) P[(ai * 128 + wr * 64 + m * 16 + fr) * 4 + wc] = ss;
      }
    __syncthreads();
    if (tid < 256) { const float t = (P[tid * 4] + P[tid * 4 + 1]) + (P[tid * 4 + 2] + P[tid * 4 + 3]);
      __hip_atomic_store(xbuf + ((size_t)u.pm * 256 + tid) * 4 + u.pn, t, __ATOMIC_RELAXED, __HIP_MEMORY_SCOPE_AGENT); }
    asm volatile("s_waitcnt vmcnt(0)" ::: "memory");
    if (wid < 4 && lane == 0) __hip_atomic_fetch_add(cnt + 64 * u.pm, 1u, __ATOMIC_RELAXED, __HIP_MEMORY_SCOPE_AGENT);
    const int b = u.pm >> 4; const int col0 = u.pn * 256 + wc * 32 + 8 * fq;
    constexpr int NE = XNE;
    f32x4 xv[NE][4];
    const float* xt = x + ((size_t)u.pm * 256 + wr * 64) * DM; float* ot = out + ((size_t)u.pm * 256 + wr * 64) * DM;
    const unsigned lo = (unsigned)(fr * DM + col0);
#pragma unroll
    for (int it = 0; it < NE; ++it) {
      const float* xr = xt + (size_t)((it >> 2) * 128 + (it & 3) * 16) * DM;
      xv[it][0] = *(const f32x4*)(xr + lo); xv[it][1] = *(const f32x4*)(xr + lo + 4); xv[it][2] = *(const f32x4*)(xr + lo + 128); xv[it][3] = *(const f32x4*)(xr + lo + 132);
    }
    if (wid == 0) {
      unsigned sp = 0;
      while ((unsigned)__builtin_amdgcn_readfirstlane(__hip_atomic_load(cnt + 64 * u.pm, __ATOMIC_RELAXED, __HIP_MEMORY_SCOPE_AGENT)) < 16u && ++sp < (1u << 22)) __builtin_amdgcn_s_sleep(2);
      __builtin_amdgcn_fence(__ATOMIC_ACQUIRE, "agent");
    }
    __syncthreads();
    if (tid < 256) { const float* xb = xbuf + ((size_t)u.pm * 256 + tid) * 4; float t = 0.f;
#pragma unroll
      for (int q = 0; q < 4; ++q) t += __hip_atomic_load(xb + q, __ATOMIC_RELAXED, __HIP_MEMORY_SCOPE_AGENT);
      S[tid] = __builtin_amdgcn_rsqf(t * (1.f / DM) + 1e-6f); }
    __syncthreads();
    const f32x4 g00 = *(const f32x4*)(gg + b * 1024 + col0), g01 = *(const f32x4*)(gg + b * 1024 + col0 + 4), g10 = *(const f32x4*)(gg + b * 1024 + col0 + 128), g11 = *(const f32x4*)(gg + b * 1024 + col0 + 132);
#define ZU(Z_) (f32x4){bflo((Z_).x), bfhi((Z_).x), bflo((Z_).y), bfhi((Z_).y)}
#pragma unroll
    for (int ai = 0; ai < 2; ++ai)
#pragma unroll
      for (int m = 0; m < 4; ++m) {
        const int rl = ai * 128 + wr * 64 + m * 16 + fr; const float r = S[rl];
        const int it = ai * 4 + m;
        const float* xr = xt + (size_t)(ai * 128 + m * 16) * DM; float* orw = ot + (size_t)(ai * 128 + m * 16) * DM;
        f32x4 x0, x1, x2, x3;
        if (it < NE) { x0 = xv[it < NE ? it : 0][0]; x1 = xv[it < NE ? it : 0][1]; x2 = xv[it < NE ? it : 0][2]; x3 = xv[it < NE ? it : 0][3]; }
        else { x0 = *(const f32x4*)(xr + lo); x1 = *(const f32x4*)(xr + lo + 4); x2 = *(const f32x4*)(xr + lo + 128); x3 = *(const f32x4*)(xr + lo + 132); }
        *(f32x4*)(orw + lo) = x0 + g00 * (ZU(zp[ai][0][m][0]) * r); *(f32x4*)(orw + lo + 4) = x1 + g01 * (ZU(zp[ai][0][m][1]) * r);
        *(f32x4*)(orw + lo + 128) = x2 + g10 * (ZU(zp[ai][1][m][0]) * r); *(f32x4*)(orw + lo + 132) = x3 + g11 * (ZU(zp[ai][1][m][1]) * r);
      }
#undef ZU
    __syncthreads();
  }
};
struct EpiPart {
  __device__ __forceinline__ void prefetch(const pg8::Unit&, int, LAS unsigned char*) const {}
  float* P; unsigned* flag;
  __device__ __forceinline__ void operator()(const f32x4 (&acc)[2][2][4][2], const pg8::Unit& u, int wr, int wc, int fr, int fq) const {
    const int row0 = wr * 64 + fr, col0 = wc * 32 + 8 * fq;
#pragma unroll
    for (int ai = 0; ai < 2; ++ai)
#pragma unroll
      for (int m = 0; m < 4; ++m) {
        const int row = row0 + ai * 128 + m * 16;
#pragma unroll
        for (int bj = 0; bj < 2; ++bj) { *(f32x4*)(P + (size_t)row * 256 + col0 + bj * 128) = acc[ai][bj][m][0]; *(f32x4*)(P + (size_t)row * 256 + col0 + bj * 128 + 4) = acc[ai][bj][m][1]; }
      }
    asm volatile("s_waitcnt vmcnt(0)" ::: "memory"); __threadfence(); __syncthreads();
    if (threadIdx.x == 0) __hip_atomic_store(flag, 1u, __ATOMIC_RELAXED, __HIP_MEMORY_SCOPE_AGENT);
  }
};
struct EpiHid {
  __device__ __forceinline__ void prefetch(const pg8::Unit&, int, LAS unsigned char*) const {}
  bf16_t* O; const float* bias; const float* P; unsigned* flag;
  __device__ __forceinline__ void operator()(const f32x4 (&acc)[2][2][4][2], const pg8::Unit& u, int wr, int wc, int fr, int fq) const {
    if (threadIdx.x == 0) { unsigned sp = 0; while (__hip_atomic_load(flag, __ATOMIC_RELAXED, __HIP_MEMORY_SCOPE_AGENT) == 0u && ++sp < (1u << 22)) __builtin_amdgcn_s_sleep(2); }
    __syncthreads(); __threadfence();
    const int row0 = wr * 64 + fr, col0 = wc * 32 + 8 * fq;
#pragma unroll
    for (int ai = 0; ai < 2; ++ai)
#pragma unroll
      for (int m = 0; m < 4; ++m) {
        const int row = row0 + ai * 128 + m * 16;
#pragma unroll
        for (int bj = 0; bj < 2; ++bj) {
          const f32x4 b0 = *(const f32x4*)(bias + col0 + bj * 128), b1 = *(const f32x4*)(bias + col0 + bj * 128 + 4);
          const f32x4 q0 = *(const f32x4*)(P + (size_t)row * 256 + col0 + bj * 128), q1 = *(const f32x4*)(P + (size_t)row * 256 + col0 + bj * 128 + 4);
          const f32x4 v0 = acc[ai][bj][m][0] + b0 + q0, v1 = acc[ai][bj][m][1] + b1 + q1;
          u32x4 w; w.x = pk2(siluf(v0[0]), siluf(v0[1])); w.y = pk2(siluf(v0[2]), siluf(v0[3])); w.z = pk2(siluf(v1[0]), siluf(v1[1])); w.w = pk2(siluf(v1[2]), siluf(v1[3]));
          *(u32x4*)(O + (size_t)row * 256 + col0 + bj * 128) = w;
        }
      }
  }
};

template <int MAP>
__device__ __forceinline__ void transpose_item(const float* W, int K, int ldw, bf16_t* WT, LAS float* scr, int nblk, int item, int lane) {
  const int kb = item / nblk, nb = item % nblk, k0 = 64 * kb, n0 = 32 * nb;
  const int nsrc = MAP ? win_actual(n0 + (lane & 31)) : n0 + (lane & 31);
#pragma unroll 8
  for (int i = 0; i < 32; ++i) { const int kk = 2 * i + (lane >> 5); scr[kk * 33 + (lane & 31)] = (nsrc >= 0) ? W[(size_t)(k0 + kk) * ldw + nsrc] : 0.f; }
  asm volatile("s_waitcnt lgkmcnt(0)" ::: "memory");
  const int c = lane & 7;
#pragma unroll
  for (int jj = 0; jj < 4; ++jj) { const int n = (lane >> 3) + 8 * jj; const LAS float* s = scr + (8 * c) * 33 + n;
    u32x4 o; o.x = pk2(s[0 * 33], s[1 * 33]); o.y = pk2(s[2 * 33], s[3 * 33]); o.z = pk2(s[4 * 33], s[5 * 33]); o.w = pk2(s[6 * 33], s[7 * 33]);
    *(u32x4*)(WT + (size_t)(n0 + n) * K + k0 + 8 * c) = o; }
  asm volatile("s_waitcnt lgkmcnt(0)" ::: "memory");
}

__device__ __forceinline__ void phase0(const Params& p, LAS unsigned char* lds) {
  int tid_ = threadIdx.x; asm volatile("" : "+v"(tid_));
  const int tid = tid_, lane = tid & 63, wave = __builtin_amdgcn_readfirstlane(tid >> 6);
  const int bid = blockIdx.x, G = gridDim.x;
  unsigned char* ws = p.ws;
  for (int item = bid; item < 48 * MOD_G; item += G) {
    const int slab = item % 48, kg = item / 48, k0 = kg * 205, k1 = (k0 + 205 < 1024) ? k0 + 205 : 1024;
    LAS float* sc = (LAS float*)lds;
    LAS float* part = (LAS float*)(lds + 32768);
    for (int i = tid; i < 8 * 1024; i += NTHREADS) sc[i] = siluf(p.c[i]);
    __syncthreads();
    const int col = slab * 64 + lane;
    float a[8] = {0.f, 0.f, 0.f, 0.f, 0.f, 0.f, 0.f, 0.f};
#pragma unroll 4
    for (int k = k0 + wave; k < k1; k += 8) {
      const float w = p.w_ada[(size_t)k * 3072 + col];
#pragma unroll
      for (int b = 0; b < 8; ++b) a[b] += sc[b * 1024 + k] * w;
    }
#pragma unroll
    for (int b = 0; b < 8; ++b) part[(wave * 8 + b) * 64 + lane] = a[b];
    __syncthreads();
    { const int b = tid >> 6; float sm = 0.f;
#pragma unroll
      for (int w = 0; w < 8; ++w) sm += part[(w * 8 + b) * 64 + lane];
      ((float*)(ws + WS_MOD))[kg * MOD_GS + b * 3072 + col] = sm; }
    __syncthreads();
  }
}

__device__ __forceinline__ void phase0b(const Params& p, LAS unsigned char* lds) {
  int tid_ = threadIdx.x; asm volatile("" : "+v"(tid_));
  const int tid = tid_, lane = tid & 63, wave = __builtin_amdgcn_readfirstlane(tid >> 6);
  const int bid = blockIdx.x, G = gridDim.x;
  unsigned char* ws = p.ws;
  for (int it = (bid + G - 48 % G) % G; it < 8; it += G) {
    const int kv = it >> 2, slab = it & 3; const float* pe = kv ? p.pe_v : p.pe_k; const float* w1 = kv ? p.w1_v : p.w1_k;
    LAS float* part = (LAS float*)lds;
    float a = 0.f; const int col = slab * 64 + lane;
    for (int k = wave * 256; k < wave * 256 + 256; ++k) a += pe[k] * w1[(size_t)k * 256 + col];
    part[wave * 64 + lane] = a;
    __syncthreads();
    if (tid < 64) { float s = 0.f;
#pragma unroll
      for (int w = 0; w < 8; ++w) s += part[w * 64 + lane];
      ((float*)(ws + WS_BIAS1))[kv * 256 + col] = s; }
    __syncthreads();
  }
  {
    LAS float* scr = (LAS float*)(lds + wave * 8704);
    const int gw = ((bid + G - 56) % G) * NWAVES + wave, NGW = G * NWAVES;
    constexpr int I_IN = 16 * 128, I_OUT = 16 * 32, I_W1 = 32 * 8, I_W2 = 4 * 2;
    constexpr int NIT = I_IN + I_OUT + 2 * I_W1 + 2 * I_W2;
    for (int it = gw; it < NIT; it += NGW) {
      int r = it;
      if (r < I_IN) { transpose_item<1>(p.w_in, 1024, 3864, (bf16_t*)(ws + WS_WIN_T), scr, 128, r, lane); continue; } r -= I_IN;
      if (r < I_OUT) { transpose_item<0>(p.w_out, 1024, 1024, (bf16_t*)(ws + WS_WOUT_T), scr, 32, r, lane); continue; } r -= I_OUT;
      if (r < I_W1) { transpose_item<0>(p.w1_k, 2048, 256, (bf16_t*)(ws + WS_W1K_T), scr, 8, r, lane); continue; } r -= I_W1;
      if (r < I_W1) { transpose_item<0>(p.w1_v, 2048, 256, (bf16_t*)(ws + WS_W1V_T), scr, 8, r, lane); continue; } r -= I_W1;
      if (r < I_W2) { transpose_item<0>(p.w2_k, 256, 64, (bf16_t*)(ws + WS_W2K_T), scr, 2, r, lane); continue; } r -= I_W2;
      transpose_item<0>(p.w2_v, 256, 64, (bf16_t*)(ws + WS_W2V_T), scr, 2, r, lane);
    }
  }
  {
    const int gt = bid * NTHREADS + tid, GT = G * NTHREADS;
    if (gt < 8 * 1024) { const int b = gt >> 10, col = gt & 1023; float v = p.b_ada[2048 + col];
      for (int g = 0; g < MOD_G; ++g) v += ((const float*)(ws + WS_MOD))[g * MOD_GS + b * 3072 + 2048 + col];
      ((float*)(ws + WS_GG))[gt] = v * p.g_post[col]; }
    float* cosr = (float*)(ws + WS_COSR); float* sinr = (float*)(ws + WS_SINR); float* cosn = (float*)(ws + WS_COSN); float* sinn = (float*)(ws + WS_SINN);
    for (int i = gt; i < MTOK * 40; i += GT) {
      const int tok = i / 40, f = i % 40;
      const float posf = (float)p.pos[tok];
      float inv; if (f < 32) inv = fexp2(-(float)f * (13.287712379549449f / 32.f)); else inv = fexp2(-(float)(f - 32) * (18.931568569324174f / 8.f));
      const float ang = posf * inv;
      const double rev = (double)ang * 0.15915494309189535; const float fr = (float)(rev - __builtin_rint(rev));
      const float cv = __builtin_amdgcn_cosf(fr), sv = __builtin_amdgcn_sinf(fr);
      if (f < 32) { cosr[(size_t)tok * 32 + f] = cv; sinr[(size_t)tok * 32 + f] = sv; } else { cosn[(size_t)tok * 8 + f - 32] = cv; sinn[(size_t)tok * 8 + f - 32] = sv; }
    }
  }
}

__device__ __forceinline__ void mod_read16(const Params& p, int b, int col0, int lane, f32x4 (&v)[4]) {
  const float* ptr = (const float*)(p.ws + WS_MOD) + b * 3072 + col0 + 4 * lane;
#pragma unroll
  for (int j = 0; j < 4; ++j) v[j] = *(const f32x4*)(p.b_ada + col0 + 4 * lane + 256 * j);
#pragma unroll 1
  for (int g = 0; g < MOD_G; ++g) {
#pragma unroll
    for (int j = 0; j < 4; ++j) v[j] = v[j] + *(const f32x4*)(ptr + 256 * j);
    ptr += MOD_GS;
  }
}
__device__ __forceinline__ void phase1(const Params& p) {
  int tid_ = threadIdx.x; asm volatile("" : "+v"(tid_));
  const int tid = tid_, lane = tid & 63, wave = tid >> 6;
  const int gw = blockIdx.x * NWAVES + wave, NGW = gridDim.x * NWAVES;
  const float* mod = (const float*)(p.ws + WS_MOD);
  bf16_t* H = (bf16_t*)(p.ws + WS_H);
  constexpr int RPW = 16;
  for (int it = gw; it < MTOK / RPW; it += NGW) {
    const int wb = it >> 3, itp = 256 * (wb & 7) + 8 * ((wb >> 3) & 31) + (it & 7);
    const int row0 = itp * RPW, b = row0 / SEQ;
    f32x4 gs[4], sh[4];
    mod_read16(p, b, 1024, lane, gs); mod_read16(p, b, 0, lane, sh);
#pragma unroll
    for (int j = 0; j < 4; ++j) { const int k = 4 * lane + 256 * j; gs[j] = *(const f32x4*)(p.g_pre + k) * (gs[j] + 1.0f); }
    const f32x4* xb = (const f32x4*)(p.x + (size_t)row0 * DM) + lane;
    f32x4 va[4], vb[4], vc[4];
#define P1_LD(V, r) do { const int r_ = (r) < RPW ? (r) : RPW - 1; _Pragma("unroll") for (int j = 0; j < 4; ++j) V[j] = xb[(size_t)r_ * (DM / 4) + 64 * j]; } while (0)
#define P1_ROW(V, r) do { float s = 0.f; _Pragma("unroll") for (int j = 0; j < 4; ++j) s += (V[j].x * V[j].x + V[j].y * V[j].y) + (V[j].z * V[j].z + V[j].w * V[j].w); \
      const float rstd = __builtin_amdgcn_rsqf(wave_sum(s) * (1.f / DM) + 1e-6f); \
      u32x2* o8 = (u32x2*)(H + (size_t)(row0 + (r)) * DM) + lane; \
      _Pragma("unroll") for (int j = 0; j < 4; ++j) { const f32x4 hv = V[j] * rstd * gs[j] + sh[j]; u32x2 w; w.x = pk2(hv.x, hv.y); w.y = pk2(hv.z, hv.w); o8[64 * j] = w; } } while (0)
    P1_LD(va, 0); P1_LD(vb, 1);
    for (int r = 0; r < RPW; r += 3) {
      P1_LD(vc, r + 2); P1_ROW(va, r);
      if (r + 1 < RPW) { P1_LD(va, r + 3); P1_ROW(vb, r + 1); }
      if (r + 2 < RPW) { P1_LD(vb, r + 4); P1_ROW(vc, r + 2); }
    }
#undef P1_LD
#undef P1_ROW
  }
}

constexpr int RS = 144;
constexpr int PRS = 272;
constexpr int R_Q = 0, R_K = 128 * RS, R_KZ = 2 * 128 * RS, R_V = 3 * 128 * RS, R_P = 4 * 128 * RS, R_RT = R_P + 128 * PRS, R_END = R_RT + 64 * RS;
static_assert(R_END <= 131072, "ret LDS");
constexpr size_t WS_KVC = WS_Z, WS_RP = WS_Z + 32 * MiB, WS_PART = WS_Z + 48 * MiB;
constexpr int CW_CMPF = 3072;
constexpr int CW_RETCNT = 1024;
__device__ __forceinline__ float ret_l2g(int h) { const float xg = fexp2(-5.f - (float)h); return -LOG2E * (xg + xg * xg * 0.5f + xg * xg * xg * (1.f / 3.f) + xg * xg * xg * xg * 0.25f + xg * xg * xg * xg * xg * 0.2f); }
__device__ __forceinline__ void reta_unit(const Params& p, LAS unsigned char* lds, int bh) {
  int tid_ = threadIdx.x; asm volatile("" : "+v"(tid_));
  const int tid = tid_, lane = tid & 63, wave = __builtin_amdgcn_readfirstlane(tid >> 6);
  const int l15 = lane & 15, g4 = lane >> 4, tq = l15 >> 2, tp = l15 & 3;
  unsigned char* ws = p.ws; const int b = bh >> 3, h = bh & 7;
  const float l2g = ret_l2g(h); const float cdec = fexp2(128.f * l2g);
  const int row0 = tid >> 3, ch = tid & 7;
  const bf16_t* RKp = (const bf16_t*)(ws + WS_RK) + ((size_t)b * SEQ + row0) * 512 + h * 64 + ch * 8;
  const bf16_t* RVp = (const bf16_t*)(ws + WS_RV) + ((size_t)b * SEQ + row0) * 512 + h * 64 + ch * 8;
  const float z0 = fexp2((float)(127 - row0) * l2g), z1 = fexp2((float)(63 - row0) * l2g);
  bf16_t* RP = (bf16_t*)(ws + WS_RP) + (size_t)(bh * 32) * 4096;
  f32x4 racc[2] = {{0.f, 0.f, 0.f, 0.f}, {0.f, 0.f, 0.f, 0.f}};
  const int dt = wave >> 1, et0 = 2 * (wave & 1);
  constexpr int BUFB = 2 * 128 * RS;
#define RA_LOAD(K0, K1, V0, V1, n) do { const int n_ = (n) < 31 ? (n) : 30; const size_t o_ = (size_t)n_ * 128 * 512; \
    K0 = *(const u32x4*)(RKp + o_); K1 = *(const u32x4*)(RKp + o_ + 64 * 512); V0 = *(const u32x4*)(RVp + o_); V1 = *(const u32x4*)(RVp + o_ + 64 * 512); } while (0)
#define RA_KZ(KV_, ZS_) (u32x4){pk2(bflo((KV_).x) * (ZS_), bfhi((KV_).x) * (ZS_)), pk2(bflo((KV_).y) * (ZS_), bfhi((KV_).y) * (ZS_)), pk2(bflo((KV_).z) * (ZS_), bfhi((KV_).z) * (ZS_)), pk2(bflo((KV_).w) * (ZS_), bfhi((KV_).w) * (ZS_))}
#define RA_STEP(K0, K1, V0, V1, n) do { \
    LAS unsigned char* bf_ = lds + ((n) & 1) * BUFB; const int lo_ = row0 * RS + ch * 16; \
    *(LAS u32x4*)(bf_ + lo_) = RA_KZ(K0, z0); *(LAS u32x4*)(bf_ + lo_ + 64 * RS) = RA_KZ(K1, z1); \
    *(LAS u32x4*)(bf_ + 128 * RS + lo_) = V0; *(LAS u32x4*)(bf_ + 128 * RS + lo_ + 64 * RS) = V1; \
    RA_LOAD(K0, K1, V0, V1, (n) + 3); \
    __syncthreads(); \
    racc[0] = racc[0] * cdec; racc[1] = racc[1] * cdec; \
    _Pragma("unroll") for (int ks = 0; ks < 4; ++ks) { \
      const LAS unsigned char* ka = bf_ + (32 * ks + 8 * g4 + tq) * RS + (16 * dt + 4 * tp) * 2; \
      const bf16x8 af = cat8(tr16(ka), tr16(ka + 4 * RS)); \
      _Pragma("unroll") for (int t = 0; t < 2; ++t) { const LAS unsigned char* va = bf_ + 128 * RS + (32 * ks + 8 * g4 + tq) * RS + (16 * (et0 + t) + 4 * tp) * 2; \
        const bf16x8 bfr = cat8(tr16(va), tr16(va + 4 * RS)); racc[t] = MFMA16(af, bfr, racc[t]); } } \
    { bf16_t* dst_ = RP + (size_t)((n) + 1) * 4096; \
      _Pragma("unroll") for (int t = 0; t < 2; ++t) _Pragma("unroll") for (int r = 0; r < 4; ++r) dst_[(16 * dt + 4 * g4 + r) * 64 + 16 * (et0 + t) + l15] = f2bf(racc[t][r]); } \
  } while (0)
  u32x4 ka0, ka1, va0, va1, kb0, kb1, vb0, vb1, kc0, kc1, vc0, vc1;
  RA_LOAD(ka0, ka1, va0, va1, 0); RA_LOAD(kb0, kb1, vb0, vb1, 1); RA_LOAD(kc0, kc1, vc0, vc1, 2);
  for (int n = 0; n < 30; n += 3) { RA_STEP(ka0, ka1, va0, va1, n); RA_STEP(kb0, kb1, vb0, vb1, n + 1); RA_STEP(kc0, kc1, vc0, vc1, n + 2); }
  RA_STEP(ka0, ka1, va0, va1, 30);
#undef RA_LOAD
#undef RA_KZ
#undef RA_STEP
  __syncthreads();
}
constexpr int R_RG = R_KZ;
struct RbRegs { u32x4 q0, q1, k0, k1, v0, v1, g0, g1, r; };
__device__ __forceinline__ float row16_sum(float v) {
  v += __int_as_float(__builtin_amdgcn_mov_dpp(__float_as_int(v), 0xB1, 0xF, 0xF, true));
  v += __int_as_float(__builtin_amdgcn_mov_dpp(__float_as_int(v), 0x4E, 0xF, 0xF, true));
  v += __int_as_float(__builtin_amdgcn_mov_dpp(__float_as_int(v), 0x141, 0xF, 0xF, true));
  v += __int_as_float(__builtin_amdgcn_mov_dpp(__float_as_int(v), 0x140, 0xF, 0xF, true));
  return v;
}
__device__ __forceinline__ void retb_load(const Params& p, int tid, int bh, int n, RbRegs& R) {
  unsigned char* ws = p.ws; const int b = bh >> 3, h = bh & 7;
  const size_t go = ((size_t)b * SEQ + (size_t)n * 128 + (tid >> 3)) * 512 + h * 64 + (tid & 7) * 8;
  const bf16_t* RQ = (const bf16_t*)(ws + WS_RQ); const bf16_t* RK = (const bf16_t*)(ws + WS_RK); const bf16_t* RV = (const bf16_t*)(ws + WS_RV); const bf16_t* RG = (const bf16_t*)(ws + WS_RG);
  R.q0 = *(const u32x4*)(RQ + go); R.q1 = *(const u32x4*)(RQ + go + 64 * 512); R.k0 = *(const u32x4*)(RK + go); R.k1 = *(const u32x4*)(RK + go + 64 * 512);
  R.v0 = *(const u32x4*)(RV + go); R.v1 = *(const u32x4*)(RV + go + 64 * 512); R.g0 = *(const u32x4*)(RG + go); R.g1 = *(const u32x4*)(RG + go + 64 * 512);
  const int nr = n > 0 ? n : 1;
  R.r = *(const u32x4*)((const bf16_t*)(ws + WS_RP) + (size_t)(bh * 32 + nr) * 4096 + (tid >> 3) * 64 + (tid & 7) * 8);
}
__device__ __forceinline__ void retb_commit(LAS unsigned char* lds, int tid, const RbRegs& R) {
  const int lo = (tid >> 3) * RS + (tid & 7) * 16;
  *(LAS u32x4*)(lds + R_Q + lo) = R.q0; *(LAS u32x4*)(lds + R_Q + lo + 64 * RS) = R.q1; *(LAS u32x4*)(lds + R_K + lo) = R.k0; *(LAS u32x4*)(lds + R_K + lo + 64 * RS) = R.k1;
  *(LAS u32x4*)(lds + R_V + lo) = R.v0; *(LAS u32x4*)(lds + R_V + lo + 64 * RS) = R.v1; *(LAS u32x4*)(lds + R_RG + lo) = R.g0; *(LAS u32x4*)(lds + R_RG + lo + 64 * RS) = R.g1;
  *(LAS u32x4*)(lds + R_RT + lo) = R.r;
}
__device__ __forceinline__ void retb_compute(const Params& p, LAS unsigned char* lds, int tid, int bh, int n) {
  const int lane = tid & 63, wave = __builtin_amdgcn_readfirstlane(tid >> 6);
  const int l15 = lane & 15, g4 = lane >> 4, tq = l15 >> 2, tp = l15 & 3;
  unsigned char* ws = p.ws; const int b = bh >> 3, h = bh & 7;
  bf16_t* MIX = (bf16_t*)(ws + WS_H);
  const float l2g = ret_l2g(h);
  const int it = wave;
  const size_t tok0 = (size_t)b * SEQ + (size_t)n * 128;
  bf16x8 aq[2];
#pragma unroll
  for (int ks = 0; ks < 2; ++ks) aq[ks] = *(const LAS bf16x8*)(lds + R_Q + (16 * it + l15) * RS + (32 * ks + 8 * g4) * 2);
  const int jt_end = it | 1;
  for (int jt = 0; jt <= jt_end; ++jt) {
    f32x4 sv = {0.f, 0.f, 0.f, 0.f};
#pragma unroll
    for (int ks = 0; ks < 2; ++ks) { const bf16x8 bk = *(const LAS bf16x8*)(lds + R_K + (16 * jt + l15) * RS + (32 * ks + 8 * g4) * 2); sv = MFMA16(aq[ks], bk, sv); }
    const int jj = 16 * jt + l15;
#pragma unroll
    for (int r = 0; r < 4; ++r) { const int ii = 16 * it + 4 * g4 + r; const int df = ii - jj; const float v = (df >= 0) ? sv[r] * fexp2((float)df * l2g) : 0.f; *(LAS bf16_t*)(lds + R_P + ii * PRS + jj * 2) = f2bf(v); }
  }
  f32x4 oin[4], ocr[4];
#pragma unroll
  for (int et = 0; et < 4; ++et) { oin[et] = (f32x4){0.f, 0.f, 0.f, 0.f}; ocr[et] = (f32x4){0.f, 0.f, 0.f, 0.f}; }
  const int ks_end = it >> 1;
  for (int ks = 0; ks <= ks_end; ++ks) {
    const bf16x8 ap = *(const LAS bf16x8*)(lds + R_P + (16 * it + l15) * PRS + (32 * ks + 8 * g4) * 2);
#pragma unroll
    for (int et = 0; et < 4; ++et) { const LAS unsigned char* va = lds + R_V + (32 * ks + 8 * g4 + tq) * RS + (16 * et + 4 * tp) * 2; const bf16x8 bfr = cat8(tr16(va), tr16(va + 4 * RS)); oin[et] = MFMA16(ap, bfr, oin[et]); }
  }
  if (n > 0) {
#pragma unroll
    for (int ks = 0; ks < 2; ++ks)
#pragma unroll
      for (int et = 0; et < 4; ++et) { const LAS unsigned char* ra = lds + R_RT + (32 * ks + 8 * g4 + tq) * RS + (16 * et + 4 * tp) * 2; const bf16x8 br = cat8(tr16(ra), tr16(ra + 4 * RS)); ocr[et] = MFMA16(aq[ks], br, ocr[et]); }
  }
  {
    float o[4][4], sm[4], qv[4];
#pragma unroll
    for (int r = 0; r < 4; ++r) {
      const int ii = 16 * it + 4 * g4 + r; const float xi = fexp2((float)(ii + 1) * l2g);
      sm[r] = 0.f;
#pragma unroll
      for (int et = 0; et < 4; ++et) { o[r][et] = oin[et][r] + xi * ocr[et][r]; sm[r] += o[r][et]; }
    }
#pragma unroll
    for (int r = 0; r < 4; ++r) sm[r] = row16_sum(sm[r]);
#pragma unroll
    for (int r = 0; r < 4; ++r) { const float mu = sm[r] * (1.f / 64.f); qv[r] = 0.f;
#pragma unroll
      for (int et = 0; et < 4; ++et) { o[r][et] -= mu; qv[r] += o[r][et] * o[r][et]; } }
#pragma unroll
    for (int r = 0; r < 4; ++r) qv[r] = row16_sum(qv[r]);
#pragma unroll
    for (int r = 0; r < 4; ++r) {
      const int ii = 16 * it + 4 * g4 + r; const float rstd = __builtin_amdgcn_rsqf(qv[r] * (1.f / 64.f) + 1e-5f);
#pragma unroll
      for (int et = 0; et < 4; ++et) { const int e = 16 * et + l15; const float gv = bf2f(*(const LAS bf16_t*)(lds + R_RG + ii * RS + e * 2)); *(LAS bf16_t*)(lds + R_Q + ii * RS + e * 2) = f2bf(o[r][et] * rstd * siluf(gv)); }
    }
  }
#pragma unroll
  for (int i = 0; i < 2; ++i) { const int row = 16 * it + (lane >> 2), ch = (lane & 3) * 2 + i; const u32x4 w = *(const LAS u32x4*)(lds + R_Q + row * RS + ch * 16); *(u32x4*)(MIX + (tok0 + row) * DM + h * 64 + ch * 8) = w; }
}
#ifndef RETB_CPU
#define RETB_CPU 4
#endif
__device__ __forceinline__ void retb_unit(const Params& p, LAS unsigned char* lds, int bh, int nq) {
  int tid_ = threadIdx.x; asm volatile("" : "+v"(tid_));
  const int tid = tid_;
  constexpr int CPU = RETB_CPU;
  RbRegs R;
  retb_load(p, tid, bh, CPU * nq, R); retb_commit(lds, tid, R);
  __syncthreads();
#pragma unroll
  for (int c = 0; c < CPU; ++c) {
    if (c + 1 < CPU) retb_load(p, tid, bh, CPU * nq + c + 1, R);
    retb_compute(p, lds, tid, bh, CPU * nq + c);
    __syncthreads();
    if (c + 1 < CPU) { retb_commit(lds, tid, R); __syncthreads(); }
  }
}

__device__ __forceinline__ void phase6(const Params& p) {
  int tid_ = threadIdx.x; asm volatile("" : "+v"(tid_));
  const int tid = tid_, lane = tid & 63, wave = tid >> 6;
  const int gw = blockIdx.x * NWAVES + wave, NGW = gridDim.x * NWAVES;
  const float* mod = (const float*)(p.ws + WS_MOD);
  const bf16_t* Z = (const bf16_t*)(p.ws + WS_Z);
  constexpr int RPW = 16;
  for (int it = gw; it < MTOK / RPW; it += NGW) {
    const int row0 = it * RPW, b = row0 / SEQ;
    f32x4 gg[4];
    mod_read16(p, b, 2048, lane, gg);
#pragma unroll
    for (int j = 0; j < 4; ++j) { const int k = 4 * lane + 256 * j; gg[j] = *(const f32x4*)(p.g_post + k) * gg[j]; }
    for (int r = 0; r < RPW; r += 2) {
      const int row = row0 + r;
      const f32x4* xr = (const f32x4*)(p.x + (size_t)row * DM) + lane; const u32x2* zr = (const u32x2*)(Z + (size_t)row * DM) + lane;
      f32x4* orow = (f32x4*)(p.out + (size_t)row * DM) + lane;
      u32x2 zv[2][4]; f32x4 xv[2][4];
#pragma unroll
      for (int q = 0; q < 2; ++q)
#pragma unroll
        for (int j = 0; j < 4; ++j) { zv[q][j] = zr[q * (DM / 4) + 64 * j]; xv[q][j] = xr[q * (DM / 4) + 64 * j]; }
#pragma unroll
      for (int q = 0; q < 2; ++q) {
        f32x4 zf[4]; float ss = 0.f;
#pragma unroll
        for (int j = 0; j < 4; ++j) { zf[j] = (f32x4){bflo(zv[q][j].x), bfhi(zv[q][j].x), bflo(zv[q][j].y), bfhi(zv[q][j].y)}; ss += (zf[j].x * zf[j].x + zf[j].y * zf[j].y) + (zf[j].z * zf[j].z + zf[j].w * zf[j].w); }
        const float rstd = __builtin_amdgcn_rsqf(wave_sum(ss) * (1.f / DM) + 1e-6f);
#pragma unroll
        for (int j = 0; j < 4; ++j) orow[q * (DM / 4) + 64 * j] = xv[q][j] + gg[j] * (zf[j] * rstd);
      }
    }
  }
}

constexpr int AT_RS = 144, AT_TILE = 64 * AT_RS;
constexpr int AT_VRS = 192, AT_VTILE = 64 * AT_VRS;
constexpr int IMP_LD = 65;
constexpr int AT_K0 = 0, AT_V0 = 2 * AT_TILE, AT_IMP = 2 * AT_TILE + 2 * AT_VTILE, AT_IMPH = AT_IMP + 64 * IMP_LD * 4, AT_MASK = AT_IMPH + 4 * 64 * IMP_LD * 4, AT_INVL = AT_MASK + 64 * 8, AT_END = AT_INVL + 4 * 64 * 4;
static_assert(AT_MASK % 8 == 0 && AT_END <= 131072, "attention LDS map");
constexpr int QW_OFF = 131072 + 1024;
struct TileSrc { const bf16_t* K; const bf16_t* V; int ld; };
__device__ __forceinline__ int crow(int r, int hi) { return (r & 3) + 8 * (r >> 2) + 4 * hi; }
__device__ __forceinline__ void at_load(const TileSrc& S, int j, int tid, u32x4& kr, u32x4& vr) {
  const int row = tid >> 3, ch = tid & 7; const unsigned lo = (unsigned)(row * S.ld + ch * 8);
  const size_t tb = (size_t)(64 * j) * S.ld;
  kr = *(const u32x4*)(S.K + tb + lo); vr = *(const u32x4*)(S.V + tb + lo);
}
__device__ __forceinline__ void at_store(LAS unsigned char* lds, int buf, int tid, u32x4 kr, u32x4 vr) {
  const int row = tid >> 3, ch = tid & 7;
  *(LAS u32x4*)(lds + AT_K0 + buf * AT_TILE + row * AT_RS + ch * 16) = kr; *(LAS u32x4*)(lds + AT_V0 + buf * AT_VTILE + row * AT_VRS + ch * 16) = vr;
}
__device__ __forceinline__ float swapmax32(float v) { auto rr = __builtin_amdgcn_permlane32_swap(__float_as_uint(v), __float_as_uint(v), false, false); return fmaxf(__uint_as_float(rr[0]), __uint_as_float(rr[1])); }
__device__ __forceinline__ float swapsum32(float v) { auto rr = __builtin_amdgcn_permlane32_swap(__float_as_uint(v), __float_as_uint(v), false, false); return __uint_as_float(rr[0]) + __uint_as_float(rr[1]); }
struct AtLane { int r32, hi, c16, tq, tp; };
template <int MODE>
__device__ __forceinline__ void attn_tile2(LAS unsigned char* lds, int cur, int j, bool MASKED, const AtLane& L, const bf16x8 (&qr)[4],
                                           int klo, int khi, float cinit, float& l, f32x16& o0, f32x16& o1, int tokl, float& carry) {
  const int r32 = L.r32, hi = L.hi;
  const LAS unsigned char* Kt = lds + AT_K0 + cur * AT_TILE; const LAS unsigned char* Vt = lds + AT_V0 + cur * AT_VTILE;
  f32x16 p0, p1;
#pragma unroll
  for (int r = 0; r < 16; ++r) { p0[r] = cinit; p1[r] = cinit; }
#pragma unroll
  for (int d0 = 0; d0 < 4; ++d0) {
    const bf16x8 a0 = *(const LAS bf16x8*)(Kt + r32 * AT_RS + (16 * d0 + 8 * hi) * 2);
    p0 = MFMA32(a0, qr[d0], p0);
  }
#pragma unroll
  for (int d0 = 0; d0 < 4; ++d0) {
    const bf16x8 a1 = *(const LAS bf16x8*)(Kt + (32 + r32) * AT_RS + (16 * d0 + 8 * hi) * 2);
    p1 = MFMA32(a1, qr[d0], p1);
  }
  if (MASKED) {
    const int kb0 = 64 * j + 4 * hi;
#pragma unroll
    for (int r = 0; r < 16; ++r) {
      const int k0 = kb0 + (r & 3) + 8 * (r >> 2), k1 = k0 + 32;
      p0[r] = (k0 >= klo && k0 <= khi) ? p0[r] : -INFINITY;
      p1[r] = (k1 >= klo && k1 <= khi) ? p1[r] : -INFINITY;
    }
  }
  float rs = 0.f;
#pragma unroll
  for (int r = 0; r < 16; ++r) p0[r] = fexp2(p0[r]);
#pragma unroll
  for (int r = 0; r < 16; ++r) rs += p0[r];
#pragma unroll
  for (int r = 0; r < 16; ++r) p1[r] = fexp2(p1[r]);
#pragma unroll
  for (int r = 0; r < 16; ++r) rs += p1[r];
  l += rs;
  if (MODE == 4) {
    float X[2][4];
#pragma unroll
    for (int q4 = 0; q4 < 4; ++q4) {
      { auto rr = __builtin_amdgcn_permlane32_swap(__float_as_uint(p0[4 * q4 + 3]), __float_as_uint(p0[4 * q4 + 3]), false, false); X[0][q4] = __uint_as_float(hi ? rr[0] : rr[1]); }
      { auto rr = __builtin_amdgcn_permlane32_swap(__float_as_uint(p1[4 * q4 + 3]), __float_as_uint(p1[4 * q4 + 3]), false, false); X[1][q4] = __uint_as_float(hi ? rr[0] : rr[1]); }
    }
    LAS float* dst = (LAS float*)(lds + AT_IMPH) + (size_t)(tokl >> 8) * (64 * IMP_LD) + (tokl & 255) * IMP_LD + 16 * j + hi;
#pragma unroll
    for (int q4 = 0; q4 < 4; ++q4) {
      const float c0 = (p0[4 * q4] + p0[4 * q4 + 1]) + (p0[4 * q4 + 2] + p0[4 * q4 + 3]), c1 = (p1[4 * q4] + p1[4 * q4 + 1]) + (p1[4 * q4 + 2] + p1[4 * q4 + 3]);
      const float e0 = hi ? X[0][q4] : (q4 ? X[0][q4 ? q4 - 1 : 0] : carry);
      const float e1 = hi ? X[1][q4] : (q4 ? X[1][q4 ? q4 - 1 : 0] : X[0][3]);
      dst[2 * q4] = c0 + e0; dst[8 + 2 * q4] = c1 + e1;
    }
    carry = X[1][3];
  }
#pragma unroll
  for (int kb = 0; kb < 2; ++kb)
#pragma unroll
    for (int sx = 0; sx < 2; ++sx) {
      u32x4 pw;
      if (kb == 0) { pw.x = pk2(p0[8 * sx], p0[8 * sx + 1]); pw.y = pk2(p0[8 * sx + 2], p0[8 * sx + 3]); pw.z = pk2(p0[8 * sx + 4], p0[8 * sx + 5]); pw.w = pk2(p0[8 * sx + 6], p0[8 * sx + 7]); }
      else { pw.x = pk2(p1[8 * sx], p1[8 * sx + 1]); pw.y = pk2(p1[8 * sx + 2], p1[8 * sx + 3]); pw.z = pk2(p1[8 * sx + 4], p1[8 * sx + 5]); pw.w = pk2(p1[8 * sx + 6], p1[8 * sx + 7]); }
      const bf16x8 pf = __builtin_bit_cast(bf16x8, pw);
      const LAS unsigned char* va = Vt + (32 * kb + 16 * sx + 4 * hi + L.tq) * AT_VRS + (16 * L.c16 + 4 * L.tp) * 2;
      const bf16x8 v0 = cat8(tr16(va), tr16(va + 8 * AT_VRS));
      const bf16x8 v1 = cat8(tr16(va + 64), tr16(va + 64 + 8 * AT_VRS));
      o0 = MFMA32(v0, pf, o0); o1 = MFMA32(v1, pf, o1);
    }
}
template <int MODE>
__device__ __forceinline__ void attn_tile(LAS unsigned char* lds, int cur, int j, bool masked, const AtLane& L, const bf16x8 (&qr)[4],
                                          int klo, int khi, unsigned long long rowmask, float negb, float& l, f32x16& o0, f32x16& o1, int tokl, float& carry) {
  const bool en = (MODE == 1) ? (((rowmask >> j) & 1ull) != 0ull) : true;
  const float cinit = (MODE == 1 && !en) ? -INFINITY : negb;
  attn_tile2<MODE>(lds, cur, j, masked, L, qr, klo, khi, cinit, l, o0, o1, tokl, carry);
}
template <int MODE, bool PRE = false>
__device__ __forceinline__ void attn_run(LAS unsigned char* lds, const TileSrc& S, unsigned long long tiles, unsigned long long mtiles, const bf16x8 (&qr)[4],
                                         int klo, int khi, unsigned long long rowmask, float negb, float& l, f32x16& o0, f32x16& o1, int tokl,
                                         u32x4 preK = (u32x4){0u, 0u, 0u, 0u}, u32x4 preV = (u32x4){0u, 0u, 0u, 0u}) {
  int tid_ = threadIdx.x; asm volatile("" : "+v"(tid_));
  const int tid = tid_, lane = tid & 63;
  AtLane L; L.r32 = lane & 31; L.hi = lane >> 5; L.c16 = (lane >> 4) & 1; L.tq = (lane & 15) >> 2; L.tp = lane & 3;
  if (tiles == 0ull) return;
  unsigned long long rem = tiles;
  int j0 = __builtin_ctzll(rem); rem &= rem - 1;
  u32x4 kA, vA, kB, vB;
#define AT_NEXT(has, jn, jprev) const bool has = rem != 0ull; const int jn = has ? __builtin_ctzll(rem) : (jprev); rem &= (rem - 1ull) & (has ? ~0ull : 0ull)
  if (PRE) { kA = preK; vA = preV; } else at_load(S, j0, tid, kA, vA);
  AT_NEXT(h1_, j1_, j0);
  bool h1 = h1_; int j1 = j1_;
  at_load(S, j1, tid, kB, vB);
  at_store(lds, 0, tid, kA, vA);
  __syncthreads();
  float carry = 0.f;
  for (;;) {
    AT_NEXT(h2, j2, j1);
    at_load(S, j2, tid, kA, vA);
    attn_tile<MODE>(lds, 0, j0, ((mtiles >> j0) & 1ull) != 0ull, L, qr, klo, khi, rowmask, negb, l, o0, o1, tokl, carry);
    at_store(lds, 1, tid, kB, vB);
    __syncthreads();
    if (!h1) break;
    AT_NEXT(h3, j3, j2);
    at_load(S, j3, tid, kB, vB);
    attn_tile<MODE>(lds, 1, j1, ((mtiles >> j1) & 1ull) != 0ull, L, qr, klo, khi, rowmask, negb, l, o0, o1, tokl, carry);
    at_store(lds, 0, tid, kA, vA);
    __syncthreads();
    if (!h2) break;
    j0 = j2; j1 = j3; h1 = h3;
  }
#undef AT_NEXT
}

__device__ __forceinline__ float at_negb(const bf16x8 (&qr)[4], const unsigned* kb, bool two) {
  float qa = 0.f, qb = 0.f;
#pragma unroll
  for (int d0 = 0; d0 < 4; ++d0)
#pragma unroll
    for (int e = 0; e < 8; e += 2) { const float x = bf2f((unsigned short)qr[d0][e]), y = bf2f((unsigned short)qr[d0][e + 1]); qa += x * x; qb += y * y; }
  const float qn2 = swapsum32(qa + qb);
  const float k2 = __uint_as_float(kb[0]) + (two ? __uint_as_float(kb[1]) : 0.f);
  return -1.01f * __builtin_sqrtf(qn2 * k2);
}
__device__ __forceinline__ void win_unit(const Params& p, LAS unsigned char* lds, int b, int g, int bi) {
  int tid_ = threadIdx.x; asm volatile("" : "+v"(tid_));
  const int tid = tid_, lane = tid & 63, wave = __builtin_amdgcn_readfirstlane(tid >> 6), r32 = lane & 31, hi = lane >> 5;
  unsigned char* ws = p.ws;
  const int hh = wave >> 1, th = wave & 1, head = 4 * g + hh, tqp = 64 * bi + 32 * th + r32; const size_t token = (size_t)b * SEQ + tqp;
  const bf16_t* NQ = (const bf16_t*)(ws + WS_NQ);
  bf16x8 qr[4];
#pragma unroll
  for (int d0 = 0; d0 < 4; ++d0) qr[d0] = *(const bf16x8*)(NQ + token * 512 + head * 64 + 16 * d0 + 8 * hi);
  const float gw = sigmoidf(bf2f(((const bf16_t*)(ws + WS_NGL))[token * 32 + head * 3 + 2]));
  TileSrc S{(const bf16_t*)(ws + WS_KV6 + 4 * KV6_STRIDE) + (size_t)b * SEQ * 128 + 64 * g, (const bf16_t*)(ws + WS_KV6 + 5 * KV6_STRIDE) + (size_t)b * SEQ * 128 + 64 * g, 128};
  const int j0 = bi >= 8 ? bi - 8 : 0;
  const unsigned long long tiles = ((2ull << bi) - 1ull) & ~((1ull << j0) - 1ull);
  const unsigned long long mtiles = (1ull << bi) | (bi >= 8 ? (1ull << (bi - 8)) : 0ull);
  float l = 0.f; f32x16 o0, o1;
#pragma unroll
  for (int r = 0; r < 16; ++r) { o0[r] = 0.f; o1[r] = 0.f; }
  const float negb = at_negb(qr, (const unsigned*)(ws + WS_CTL) + CW_KB + (16 + b * 2 + g) * 2, true);
  attn_run<0>(lds, S, tiles, mtiles, qr, tqp - 511, tqp, 0ull, negb, l, o0, o1, 0);
  const float lt = swapsum32(l); const float sc = lt > 0.f ? gw / lt : 0.f;
  LAS unsigned char* stg = lds + wave * (32 * 144);
#pragma unroll
  for (int q4 = 0; q4 < 4; ++q4) {
    u32x2 w0, w1; w0.x = pk2(o0[4 * q4] * sc, o0[4 * q4 + 1] * sc); w0.y = pk2(o0[4 * q4 + 2] * sc, o0[4 * q4 + 3] * sc);
    w1.x = pk2(o1[4 * q4] * sc, o1[4 * q4 + 1] * sc); w1.y = pk2(o1[4 * q4 + 2] * sc, o1[4 * q4 + 3] * sc);
    *(LAS u32x2*)(stg + r32 * 144 + (8 * q4 + 4 * hi) * 2) = w0; *(LAS u32x2*)(stg + r32 * 144 + (32 + 8 * q4 + 4 * hi) * 2) = w1;
  }
  bf16_t* OWb = (bf16_t*)(ws + WS_OWIN) + ((size_t)b * SEQ + 64 * bi + 32 * th) * 512 + head * 64;
#pragma unroll
  for (int it = 0; it < 4; ++it) { const int row = 8 * it + (lane >> 3), ch = lane & 7; const u32x4 v = *(const LAS u32x4*)(stg + row * 144 + ch * 16); *(u32x4*)(OWb + (size_t)row * 512 + ch * 8) = v; }
  __syncthreads();
}

__device__ __forceinline__ void sort16_desc(unsigned (&a)[16]) {
#pragma unroll
  for (int ks = 1; ks <= 4; ++ks)
#pragma unroll
    for (int js = ks - 1; js >= 0; --js)
#pragma unroll
      for (int i = 0; i < 16; ++i) {
        const int k = 1 << ks, j = 1 << js, l = i ^ j;
        if (l > i) {
          const unsigned hi = a[i] > a[l] ? a[i] : a[l], lo = a[i] > a[l] ? a[l] : a[i];
          if ((i & k) == 0) { a[i] = hi; a[l] = lo; } else { a[i] = lo; a[l] = hi; }
        }
      }
}
__device__ __forceinline__ void cs_unit(const Params& p, LAS unsigned char* lds, int b, int g, int bi) {
  int tid_ = threadIdx.x; asm volatile("" : "+v"(tid_));
  const int tid = tid_, lane = tid & 63, wave = __builtin_amdgcn_readfirstlane(tid >> 6), r32 = lane & 31, hi = lane >> 5;
  unsigned char* ws = p.ws;
  const int hh = wave >> 1, th = wave & 1, head = 4 * g + hh, tokl = 32 * th + r32, tqp = 64 * bi + tokl; const size_t token = (size_t)b * SEQ + tqp;
  const bf16_t* NQ = (const bf16_t*)(ws + WS_NQ); const bf16_t* NGLp = (const bf16_t*)(ws + WS_NGL) + token * 32 + head * 3;
  bf16x8 qr[4];
#pragma unroll
  for (int d0 = 0; d0 < 4; ++d0) qr[d0] = *(const bf16x8*)(NQ + token * 512 + head * 64 + 16 * d0 + 8 * hi);
  const float gc = sigmoidf(bf2f(NGLp[0])), gs = sigmoidf(bf2f(NGLp[1]));
  TileSrc SS{(const bf16_t*)(ws + WS_KV6 + 2 * KV6_STRIDE) + (size_t)b * SEQ * 128 + 64 * g, (const bf16_t*)(ws + WS_KV6 + 3 * KV6_STRIDE) + (size_t)b * SEQ * 128 + 64 * g, 128};
  u32x4 pks, pvs; at_load(SS, 0, tid, pks, pvs);
  const int bg = b * 2 + g;
  TileSrc SC{(const bf16_t*)(ws + WS_KCMP) + (size_t)bg * 256 * 64, (const bf16_t*)(ws + WS_VCMP) + (size_t)bg * 256 * 64, 64};
  const int nmax = (64 * bi + 63 - 31) >> 4;
  const unsigned long long ctiles = (2ull << (nmax >> 6)) - 1ull;
  const int khi_c = (tqp - 31) >> 4;
  unsigned long long cmt = 0ull;
  for (int jj = 0; jj <= (nmax >> 6); ++jj) if (64 * jj + 63 > 4 * bi - 2) cmt |= 1ull << jj;
  float l = 0.f; f32x16 o0, o1;
#pragma unroll
  for (int r = 0; r < 16; ++r) { o0[r] = 0.f; o1[r] = 0.f; }
  const unsigned* kbw = (const unsigned*)(ws + WS_CTL) + CW_KB;
  attn_run<4>(lds, SC, ctiles, cmt, qr, 0, khi_c, 0ull, at_negb(qr, kbw + (32 + bg) * 2, false), l, o0, o1, tokl | (hh << 8));
  f32x16 t0, t1;
  { const float lt = swapsum32(l); const float il = lt > 0.f ? 1.f / lt : 0.f;
    if (hi == 0) ((LAS float*)(lds + AT_INVL))[hh * 64 + tokl] = il;
    const float gi = gc * il;
#pragma unroll
    for (int r = 0; r < 16; ++r) { t0[r] = gi * o0[r]; t1[r] = gi * o1[r]; } }
  __syncthreads();
  {
    LAS unsigned long long* mk = (LAS unsigned long long*)(lds + AT_MASK);
    LAS float* imp = (LAS float*)(lds + AT_IMP);
    if (bi <= 15) { if (lane < 8) mk[8 * wave + lane] = (2ull << bi) - 1ull; }
    else {
      const LAS float* ih = (const LAS float*)(lds + AT_IMPH);
#pragma unroll
      for (int tt = 0; tt < 8; ++tt) { const int tk = 8 * wave + tt, o = tk * IMP_LD + lane; const LAS float* iv = (const LAS float*)(lds + AT_INVL) + tk;
        imp[o] = (ih[o] * iv[0] + ih[o + 64 * IMP_LD] * iv[64]) + (ih[o + 2 * 64 * IMP_LD] * iv[128] + ih[o + 3 * 64 * IMP_LD] * iv[192]); }
      __syncthreads();
      if (wave < 4) {
        const int tk0 = 16 * wave, q = lane & 3; const LAS float* irow = imp + (tk0 + (lane >> 2)) * IMP_LD + q;
        unsigned a[16];
#pragma unroll
        for (int i = 0; i < 16; ++i) { const int s = 4 * i + q; const unsigned kb = __float_as_uint(irow[4 * i]) + 1u; a[i] = (s >= 1 && s <= bi - 2) ? kb : 0u; }
        unsigned k0[16];
#pragma unroll
        for (int i = 0; i < 16; ++i) k0[i] = a[i];
        sort16_desc(a);
        unsigned m[16];
#pragma unroll
        for (int i = 0; i < 16; ++i) { const unsigned y = (unsigned)__builtin_amdgcn_mov_dpp((int)a[15 - i], 0xB1, 0xF, 0xF, true); m[i] = a[i] > y ? a[i] : y; }
#pragma unroll
        for (int js = 3; js >= 0; --js)
#pragma unroll
          for (int i = 0; i < 16; ++i) { const int l = i ^ (1 << js); if (l > i) { const unsigned hi_ = m[i] > m[l] ? m[i] : m[l], lo_ = m[i] > m[l] ? m[l] : m[i]; m[i] = hi_; m[l] = lo_; } }
        unsigned t = 0xffffffffu;
#pragma unroll
        for (int i = 0; i < 13; ++i) { const unsigned y = (unsigned)__builtin_amdgcn_mov_dpp((int)m[12 - i], 0x4E, 0xF, 0xF, true); const unsigned mx = m[i] > y ? m[i] : y; t = mx < t ? mx : t; }
        unsigned cm = 0u;
#pragma unroll
        for (int i = 0; i < 16; ++i) cm |= (k0[i] >= t ? 1u : 0u) << i;
        unsigned long long x = cm;
        x = (x | (x << 24)) & 0x000000FF000000FFull; x = (x | (x << 12)) & 0x000F000F000F000Full;
        x = (x | (x << 6)) & 0x0303030303030303ull; x = (x | (x << 3)) & 0x1111111111111111ull;
        x <<= q;
        unsigned xl = (unsigned)x, xh = (unsigned)(x >> 32);
        xl |= (unsigned)__builtin_amdgcn_mov_dpp((int)xl, 0xB1, 0xF, 0xF, true); xh |= (unsigned)__builtin_amdgcn_mov_dpp((int)xh, 0xB1, 0xF, 0xF, true);
        xl |= (unsigned)__builtin_amdgcn_mov_dpp((int)xl, 0x4E, 0xF, 0xF, true); xh |= (unsigned)__builtin_amdgcn_mov_dpp((int)xh, 0x4E, 0xF, 0xF, true);
        const bool tie = (__builtin_popcount(xl) + __builtin_popcount(xh)) != 13;
        const unsigned long long forced = 1ull | (1ull << bi) | (1ull << (bi - 1));
        if (q == 0) mk[tk0 + (lane >> 2)] = (((unsigned long long)xh << 32) | xl) | forced;
        unsigned long long todo = __ballot(tie && q == 0);
        while (todo != 0ull) {
          const int ln = __builtin_ctzll(todo); todo &= todo - 1ull;
          const int tok = tk0 + (ln >> 2);
          const unsigned T = (unsigned)__builtin_amdgcn_readlane((int)t, ln);
          const bool cand = lane >= 1 && lane <= bi - 2;
          const unsigned key = cand ? (__float_as_uint(imp[tok * IMP_LD + lane]) + 1u) : 0u;
          const unsigned long long gt = __ballot(key > T), eq = __ballot(key == T);
          const int need = 13 - (int)__builtin_popcountll(gt);
          const int below = (int)__builtin_amdgcn_mbcnt_hi((unsigned)(eq >> 32), __builtin_amdgcn_mbcnt_lo((unsigned)eq, 0u));
          const bool sel = (key > T) || (key == T && below < need);
          const unsigned long long msk = __ballot(sel) | forced;
          if (lane == 0) mk[tok] = msk;
        }
      }
    }
    __syncthreads();
  }
  const unsigned long long rowmask = ((const LAS unsigned long long*)(lds + AT_MASK))[tokl];
  unsigned long long uni = ((const LAS unsigned long long*)(lds + AT_MASK))[lane];
  { unsigned ulo = (unsigned)uni, uhi = (unsigned)(uni >> 32);
#pragma unroll
    for (int o = 1; o < 64; o <<= 1) { ulo |= __shfl_xor(ulo, o); uhi |= __shfl_xor(uhi, o); }
    uni = ((unsigned long long)(unsigned)__builtin_amdgcn_readfirstlane(uhi) << 32) | (unsigned)__builtin_amdgcn_readfirstlane(ulo); }
  __syncthreads();
  { LAS f32x4* pk = (LAS f32x4*)(lds + AT_IMPH) + tid;
#pragma unroll
    for (int k = 0; k < 4; ++k) { pk[k * 512] = (f32x4){t0[4 * k], t0[4 * k + 1], t0[4 * k + 2], t0[4 * k + 3]}; pk[(4 + k) * 512] = (f32x4){t1[4 * k], t1[4 * k + 1], t1[4 * k + 2], t1[4 * k + 3]}; } }
  u32x4 owv[4], ngv[4];
  { const size_t trow = (size_t)b * SEQ + 64 * bi + 32 * th; const bf16_t* OW = (const bf16_t*)(ws + WS_OWIN) + trow * 512 + head * 64; const bf16_t* NGp = (const bf16_t*)(ws + WS_NG) + trow * 512 + head * 64;
#pragma unroll
    for (int it = 0; it < 4; ++it) { const int row = 8 * it + (lane >> 3), ch = lane & 7; owv[it] = *(const u32x4*)(OW + (size_t)row * 512 + ch * 8); ngv[it] = *(const u32x4*)(NGp + (size_t)row * 512 + ch * 8); } }
  l = 0.f;
#pragma unroll
  for (int r = 0; r < 16; ++r) { o0[r] = 0.f; o1[r] = 0.f; }
  attn_run<1, true>(lds, SS, uni & ((2ull << bi) - 1ull), 1ull << bi, qr, 0, tqp, rowmask, at_negb(qr, kbw + bg * 2, true), l, o0, o1, tokl, pks, pvs);
  { const LAS f32x4* pk = (const LAS f32x4*)(lds + AT_IMPH) + tid;
#pragma unroll
    for (int k = 0; k < 4; ++k) { const f32x4 a = pk[k * 512], c = pk[(4 + k) * 512]; t0[4 * k] = a[0]; t0[4 * k + 1] = a[1]; t0[4 * k + 2] = a[2]; t0[4 * k + 3] = a[3]; t1[4 * k] = c[0]; t1[4 * k + 1] = c[1]; t1[4 * k + 2] = c[2]; t1[4 * k + 3] = c[3]; } }
  const float lt = swapsum32(l); const float sc = lt > 0.f ? gs / lt : 0.f;
  LAS unsigned char* stg = lds + wave * (32 * 144);
#pragma unroll
  for (int q4 = 0; q4 < 4; ++q4) {
    u32x2 w0, w1;
    w0.x = pk2(t0[4 * q4] + sc * o0[4 * q4], t0[4 * q4 + 1] + sc * o0[4 * q4 + 1]); w0.y = pk2(t0[4 * q4 + 2] + sc * o0[4 * q4 + 2], t0[4 * q4 + 3] + sc * o0[4 * q4 + 3]);
    w1.x = pk2(t1[4 * q4] + sc * o1[4 * q4], t1[4 * q4 + 1] + sc * o1[4 * q4 + 1]); w1.y = pk2(t1[4 * q4 + 2] + sc * o1[4 * q4 + 2], t1[4 * q4 + 3] + sc * o1[4 * q4 + 3]);
    *(LAS u32x2*)(stg + r32 * 144 + (8 * q4 + 4 * hi) * 2) = w0; *(LAS u32x2*)(stg + r32 * 144 + (32 + 8 * q4 + 4 * hi) * 2) = w1;
  }
  bf16_t* MXb = (bf16_t*)(ws + WS_H) + ((size_t)b * SEQ + 64 * bi + 32 * th) * DM + 512 + head * 64;
#pragma unroll
  for (int it = 0; it < 4; ++it) {
    const int row = 8 * it + (lane >> 3), ch = lane & 7;
    const u32x4 a = *(const LAS u32x4*)(stg + row * 144 + ch * 16); const u32x4 ow = owv[it], ng = ngv[it];
    u32x4 w;
    w.x = pk2((bflo(a.x) + bflo(ow.x)) * siluf(bflo(ng.x)), (bfhi(a.x) + bfhi(ow.x)) * siluf(bfhi(ng.x)));
    w.y = pk2((bflo(a.y) + bflo(ow.y)) * siluf(bflo(ng.y)), (bfhi(a.y) + bfhi(ow.y)) * siluf(bfhi(ng.y)));
    w.z = pk2((bflo(a.z) + bflo(ow.z)) * siluf(bflo(ng.z)), (bfhi(a.z) + bfhi(ow.z)) * siluf(bfhi(ng.z)));
    w.w = pk2((bflo(a.w) + bflo(ow.w)) * siluf(bflo(ng.w)), (bfhi(a.w) + bfhi(ow.w)) * siluf(bfhi(ng.w)));
    *(u32x4*)(MXb + (size_t)row * DM + ch * 8) = w;
  }
  __syncthreads();
}

__device__ __forceinline__ void compress_unit(const Params& p, LAS unsigned char* lds, int cu, int half) {
  unsigned char* ws = p.ws;
  const int kv = cu >> 4, bg = cu & 15, b = bg >> 1, g = bg & 1;
  bf16_t* HID = (bf16_t*)(ws + WS_HID) + ((size_t)kv * 4096 + bg * 256) * 256;
  float* PART = (float*)(ws + WS_PART) + (size_t)cu * 65536;
  unsigned* flag = (unsigned*)(ws + WS_CTL) + CW_CMPF + 16 * cu;
  {
    pg8::Gemm gm{(const bf16_t*)(ws + WS_KV6 + (size_t)kv * KV6_STRIDE) + ((size_t)b * SEQ + 16 * half) * 128 + 64 * g, (const bf16_t*)(ws + (kv ? WS_W1V_T : WS_W1K_T)) + 1024 * half, 256, 256, 1024, 2048, 256, 2048};
    pg8::OneUnit S{1};
    if (half == 0) { EpiPart E{PART, flag}; pg8::gemm_phase<EpiPart, pg8::OneUnit>(lds, gm, S, E); return; }
    EpiHid E{HID, (const float*)(ws + WS_BIAS1) + kv * 256, PART, flag};
    pg8::gemm_phase<EpiHid, pg8::OneUnit>(lds, gm, S, E);
  }
  asm volatile("s_waitcnt vmcnt(0)" ::: "memory"); __threadfence(); __syncthreads();
  int tid_ = threadIdx.x; asm volatile("" : "+v"(tid_));
  const int tid = tid_, lane = tid & 63, wave = __builtin_amdgcn_readfirstlane(tid >> 6), l15 = lane & 15, g4 = lane >> 4;
  const bf16_t* W2 = (const bf16_t*)(ws + (kv ? WS_W2V_T : WS_W2K_T));
  f32x4 acc[2][4];
#pragma unroll
  for (int t = 0; t < 2; ++t)
#pragma unroll
    for (int ct = 0; ct < 4; ++ct) acc[t][ct] = (f32x4){0.f, 0.f, 0.f, 0.f};
  for (int ks = 0; ks < 8; ++ks) {
    bf16x8 a[2];
#pragma unroll
    for (int t = 0; t < 2; ++t) a[t] = *(const bf16x8*)(HID + (size_t)(16 * (2 * wave + t) + l15) * 256 + 32 * ks + 8 * g4);
#pragma unroll
    for (int ct = 0; ct < 4; ++ct) { const bf16x8 bw = *(const bf16x8*)(W2 + (size_t)(16 * ct + l15) * 256 + 32 * ks + 8 * g4);
#pragma unroll
      for (int t = 0; t < 2; ++t) acc[t][ct] = MFMA16(a[t], bw, acc[t][ct]); }
  }
  bf16_t* OUT = (bf16_t*)(ws + (kv ? WS_VCMP : WS_KCMP)) + (size_t)bg * 256 * 64;
  const float* cosn = (const float*)(ws + WS_COSN); const float* sinn = (const float*)(ws + WS_SINN);
  float kmx = 0.f;
#pragma unroll
  for (int t = 0; t < 2; ++t)
#pragma unroll
    for (int r = 0; r < 4; ++r) {
      const int n = 16 * (2 * wave + t) + 4 * g4 + r; const int nc = n < 255 ? n : 254;
      const size_t tp = (size_t)b * SEQ + 16 * nc + 31;
      float ss = 0.f;
#pragma unroll
      for (int ct = 0; ct < 4; ++ct) {
        float x = acc[t][ct][r]; int e = 16 * ct + l15;
        if (ct == 0) {
          const float pr = __shfl_xor(x, 8);
          if (kv == 0) { const int f = l15 & 7; const float cs = cosn[tp * 8 + f], sn = sinn[tp * 8 + f];
            x = (l15 < 8) ? x * cs - pr * sn : pr * sn + x * cs;
            e = (l15 < 4) ? l15 : (l15 < 8) ? l15 + 4 : (l15 < 12) ? l15 - 4 : l15; }
        }
        OUT[(size_t)n * 64 + e] = (n < 255) ? f2bf(x) : (bf16_t)0;
        ss += x * x;
      }
      if (kv == 0) {
#pragma unroll
        for (int o = 1; o < 16; o <<= 1) ss += __shfl_xor(ss, o);
        kmx = fmaxf(kmx, (n < 255) ? ss : 0.f);
      }
    }
  if (kv == 0) {
    kmx = fmaxf(kmx, __shfl_xor(kmx, 16)); kmx = fmaxf(kmx, __shfl_xor(kmx, 32));
    if (lane == 0) atomicMax((unsigned*)(ws + WS_CTL) + CW_KB + (2 * 16 + bg) * 2, __float_as_uint(kmx));
  }
}

#define XB_TMO      128
#define XB_XCNT(j)  (256  + 64 * (j))
#define XB_XSUB(j)  (1280 + 64 * (j))
#define XB_XGEN(j)  (2304 + 64 * (j))
#define XB_TOP      3328
#define XB_TOPGEN   3392
#define XCD_BAR_WORDS 3456
#define XB_SPIN_CAP (1u << 20)
constexpr int CW_BAR = 4096;
constexpr int XBST_OFF = 131072 + 2048;
__device__ __forceinline__ unsigned xb_ld(unsigned* p)              { return __hip_atomic_load(p, __ATOMIC_RELAXED, __HIP_MEMORY_SCOPE_AGENT); }
__device__ __forceinline__ unsigned xb_add(unsigned* p, unsigned v) { return __hip_atomic_fetch_add(p, v, __ATOMIC_RELAXED, __HIP_MEMORY_SCOPE_AGENT); }
__device__ __forceinline__ unsigned xb_xcc_id() { return (unsigned)__builtin_amdgcn_s_getreg((3 << 11) | 20) & 0xFu; }
#define XB_SPIN(cond, bar) do { unsigned _sp = 0; while (cond) { __builtin_amdgcn_s_sleep(1); \
    if ((++_sp & 255u) == 0u) { if (xb_ld(&(bar)[XB_TMO])) break; if (_sp > XB_SPIN_CAP) { atomicAdd(&(bar)[XB_TMO], 1u); break; } } } } while (0)
struct XcdBarrier { unsigned* bar; unsigned x; volatile LAS unsigned* st; };
__device__ __forceinline__ XcdBarrier xcd_barrier_post(unsigned* bar, volatile LAS unsigned* st) {
  XcdBarrier b; b.bar = bar; b.x = xb_xcc_id(); b.st = st;
  if (threadIdx.x == 0) (void)xb_add(&bar[XB_XCNT(b.x)], 1u);
  return b;
}
__device__ __forceinline__ void xcd_barrier_complete(unsigned* bar, unsigned x, unsigned& nloc, unsigned& nx) {
  const unsigned G = gridDim.x * gridDim.y * gridDim.z;
  unsigned sum, cnt, mine, sp = 0u;
  for (;;) {
    sum = 0u; cnt = 0u; mine = 0u;
#pragma unroll
    for (unsigned j = 0; j < 16; ++j) { const unsigned c = xb_ld(&bar[XB_XCNT(j)]); sum += c; cnt += (c > 0u) ? 1u : 0u; mine = (j == x) ? c : mine; }
    if (sum == G) break;
    __builtin_amdgcn_s_sleep(1);
    if ((++sp & 255u) == 0u) { if (xb_ld(&bar[XB_TMO])) break; if (sp > XB_SPIN_CAP) { atomicAdd(&bar[XB_TMO], 1u); break; } }
  }
  nloc = mine > 0u ? mine : 1u; nx = cnt > 0u ? cnt : 1u;
}
__device__ __forceinline__ void xcd_barrier(const XcdBarrier& b) {
  asm volatile("s_waitcnt vmcnt(0)" ::: "memory");
  __syncthreads();
  if (threadIdx.x == 0) {
    unsigned* bar = b.bar;
    __builtin_amdgcn_s_waitcnt(0);
    unsigned nloc = b.st[0], nx = b.st[1];
    if (nloc == 0u) { xcd_barrier_complete(bar, b.x, nloc, nx); b.st[0] = nloc; b.st[1] = nx; }
    const unsigned old = xb_add(&bar[XB_XSUB(b.x)], 1u);
    const unsigned gen = old / nloc;
    if (old + 1u == (gen + 1u) * nloc) {
      __builtin_amdgcn_fence(__ATOMIC_RELEASE, "agent");
      asm volatile("s_waitcnt vmcnt(0)" ::: "memory");
      const unsigned og = xb_add(&bar[XB_TOP], 1u);
      const unsigned tg = og / nx;
      if (og + 1u == (tg + 1u) * nx) xb_add(&bar[XB_TOPGEN], 1u);
      else XB_SPIN(xb_ld(&bar[XB_TOPGEN]) == tg, bar);
      __builtin_amdgcn_fence(__ATOMIC_ACQUIRE, "agent");
      xb_add(&bar[XB_XGEN(b.x)], 1u);
      asm volatile("s_waitcnt vmcnt(0)" ::: "memory");
    } else {
      XB_SPIN(xb_ld(&bar[XB_XGEN(b.x)]) == gen, bar);
      __builtin_amdgcn_fence(__ATOMIC_ACQUIRE, "agent");
      asm volatile("s_waitcnt vmcnt(0)" ::: "memory");
    }
  }
  __syncthreads();
}

__global__ void __launch_bounds__(NTHREADS, 2) fwd_megakernel(Params p) {
  extern __shared__ __attribute__((aligned(16))) unsigned char lds_raw[];
  LAS unsigned char* lds = (LAS unsigned char*)lds_raw;
  const int lo = p.ph_lo, hi = p.ph_hi;
  unsigned char* ws = p.ws;
  if (threadIdx.x < 2) ((LAS unsigned*)(lds + XBST_OFF))[threadIdx.x] = 0u;
  __syncthreads();
  XcdBarrier bar = xcd_barrier_post((unsigned*)(ws + WS_CTL) + CW_BAR, (volatile LAS unsigned*)(lds + XBST_OFF));
#define IN(k) (lo <= (k) && (k) < hi)
#define SEAM(k) do { if (IN(k) && IN((k) + 1)) xcd_barrier(bar); } while (0)
  if (IN(0)) phase0(p, lds);
  SEAM(0);
  if (IN(1)) { phase1(p); phase0b(p, lds); }
  SEAM(1);
  if (IN(2)) {
    pg8::Gemm g{(const bf16_t*)(ws + WS_H), (const bf16_t*)(ws + WS_WIN_T), MTOK, NPROJ, DM, DM, 128, DM};
    pg8::StaticOrder S; S.init(MTOK, NPROJ, gridDim.x, blockIdx.x, WGM_P2);
    EpiProj E{ws};
    pg8::gemm_phase<EpiProj, pg8::StaticOrder>(lds, g, S, E);
  }
  SEAM(2);
#define QFETCH(dst, ctrp) do { __syncthreads(); if (threadIdx.x == 0) *(LAS int*)(lds + QW_OFF) = (int)atomicAdd((ctrp), 1u); __syncthreads(); dst = *(LAS int*)(lds + QW_OFF); } while (0)
  if (IN(3)) {
    unsigned* ctr0 = (unsigned*)(ws + WS_CTL) + CW_Q3;
    constexpr int NQ3 = 8 + 8 + 128;
    int qx = (int)(bar.x & 7u), hops = 0, u;
    QFETCH(u, ctr0 + 16 * qx);
    for (;;) {
      while (u >= NQ3 && hops < 7) { ++hops; qx = (qx + 1) & 7; QFETCH(u, ctr0 + 16 * qx); }
      if (u >= NQ3) break;
      int nx = 0; if (threadIdx.x == 0) nx = (int)atomicAdd(ctr0 + 16 * qx, 1u);
      if (u < 8) compress_unit(p, lds, ((u & 3) >> 1) * 16 + 2 * qx + (u & 1), u >> 2);
      else if (u < 16) reta_unit(p, lds, 8 * qx + (u - 8));
      else { const int w = u - 16; win_unit(p, lds, qx, w & 1, 63 - (w >> 1)); }
      if (threadIdx.x == 0) *(LAS int*)(lds + QW_OFF) = nx;
      __syncthreads();
      u = *(LAS int*)(lds + QW_OFF);
    }
  }
  SEAM(3);
  if (IN(4)) {
    unsigned* ctr0 = (unsigned*)(ws + WS_CTL) + CW_Q4;
    constexpr int NRB = 8 * (32 / RETB_CPU);
    constexpr int NQ4 = 128 + NRB;
    int qx = (int)(bar.x & 7u), hops = 0, u;
    QFETCH(u, ctr0 + 16 * qx);
    for (;;) {
      while (u >= NQ4 && hops < 7) { ++hops; qx = (qx + 1) & 7; QFETCH(u, ctr0 + 16 * qx); }
      if (u >= NQ4) break;
      int nx = 0; if (threadIdx.x == 0) nx = (int)atomicAdd(ctr0 + 16 * qx, 1u);
      if (u < 112) cs_unit(p, lds, qx, u & 1, 63 - (u >> 1));
      else if (u < 112 + NRB) { const int r = u - 112; retb_unit(p, lds, 8 * qx + r / (32 / RETB_CPU), r % (32 / RETB_CPU)); }
      else { const int c = u - NRB; cs_unit(p, lds, qx, c & 1, 63 - (c >> 1)); }
      if (threadIdx.x == 0) *(LAS int*)(lds + QW_OFF) = nx;
      __syncthreads();
      u = *(LAS int*)(lds + QW_OFF);
    }
  }
  SEAM(4);
  const bool fused_out = (gridDim.x == 256);
  if (IN(5)) {
    pg8::Gemm g{(const bf16_t*)(ws + WS_H), (const bf16_t*)(ws + WS_WOUT_T), MTOK, DM, DM, DM, 128, DM};
    pg8::StaticOrder S; S.init(MTOK, DM, gridDim.x, blockIdx.x, WGM_P5);
    if (fused_out) {
      EpiOut E{p.x, p.out, (const float*)(ws + WS_GG), (float*)(ws + WS_ROWSS), (unsigned*)(ws + WS_CTL) + CW_PANEL, lds};
      pg8::gemm_phase<EpiOut, pg8::StaticOrder>(lds, g, S, E);
    } else {
      EpiZ E{(bf16_t*)(ws + WS_Z), (float*)(ws + WS_ROWSS)};
      pg8::gemm_phase<EpiZ, pg8::StaticOrder>(lds, g, S, E);
    }
  }
  if (!fused_out) {
    SEAM(5);
    if (IN(6)) phase6(p);
  }
#undef IN
#undef SEAM
}

extern "C" void kernel_launch(void* const* d_in, const int* in_sizes, int n_in,
                              void* d_out, int out_size, void* d_ws, size_t ws_size,
                              hipStream_t stream) {
  static int grid_blocks = 0;
  if (!grid_blocks) {
    if (n_in != 15 || out_size != MTOK * DM || ws_size < WS_END) { fprintf(stderr, "kernel_launch: unexpected shapes (n_in %d out %d ws %zu)\n", n_in, out_size, ws_size); grid_blocks = -1; return; }
    int dev = 0, cus = 0, per_cu = 0;
    hipGetDevice(&dev);
    hipDeviceGetAttribute(&cus, hipDeviceAttributeMultiprocessorCount, dev);
    hipFuncSetAttribute((const void*)fwd_megakernel, hipFuncAttributeMaxDynamicSharedMemorySize, LDS_BYTES);
    hipOccupancyMaxActiveBlocksPerMultiprocessor(&per_cu, (const void*)fwd_megakernel, NTHREADS, LDS_BYTES);
    if (per_cu < 1) per_cu = 1;
    grid_blocks = cus * 1;
    fprintf(stderr, "grid %d (cus %d per_cu %d)\n", grid_blocks, cus, per_cu);
  }
  if (grid_blocks < 0) return;
  hipMemsetAsync((char*)d_ws + WS_CTL, 0, CTL_USED, stream);
  Params p{};
  p.x = (const float*)d_in[0]; p.c = (const float*)d_in[1]; p.pos = (const int*)d_in[2]; p.w_ada = (const float*)d_in[3]; p.b_ada = (const float*)d_in[4];
  p.g_pre = (const float*)d_in[5]; p.g_post = (const float*)d_in[6]; p.w_in = (const float*)d_in[7]; p.w_out = (const float*)d_in[8];
  p.pe_k = (const float*)d_in[9]; p.w1_k = (const float*)d_in[10]; p.w2_k = (const float*)d_in[11]; p.pe_v = (const float*)d_in[12]; p.w1_v = (const float*)d_in[13]; p.w2_v = (const float*)d_in[14];
  p.out = (float*)d_out; p.ws = (unsigned char*)d_ws; p.ph_lo = 0; p.ph_hi = 7;
  void* args[] = {&p};
  hipError_t e = hipLaunchCooperativeKernel((const void*)fwd_megakernel, dim3(grid_blocks), dim3(NTHREADS), args, LDS_BYTES, stream);
  if (e != hipSuccess) fprintf(stderr, "cooperative launch failed: %s (grid %d)\n", hipGetErrorString(e), grid_blocks);
}
```

```cpp
#include <hip/hip_runtime.h>
#include <hip/hip_cooperative_groups.h>
#include <cstdio>
#include <cstdint>
namespace cg = cooperative_groups;

#define LAS __attribute__((address_space(3)))
typedef unsigned short bf16_t;
typedef short bf16x8 __attribute__((ext_vector_type(8)));
typedef short s16x4 __attribute__((ext_vector_type(4)));
typedef float f32x2 __attribute__((ext_vector_type(2)));
typedef float f32x4 __attribute__((ext_vector_type(4)));
typedef float f32x16 __attribute__((ext_vector_type(16)));
typedef unsigned u32x2 __attribute__((ext_vector_type(2)));
typedef unsigned u32x4 __attribute__((ext_vector_type(4)));
typedef __bf16 bf16x2_t __attribute__((ext_vector_type(2)));

constexpr int NB = 8, SEQ = 4096, DM = 1024, MTOK = NB * SEQ;
constexpr int NPROJ = 4096;
constexpr int NTHREADS = 512, NWAVES = 8;
constexpr float LOG2E = 1.4426950408889634f;

constexpr size_t MiB = 1u << 20;
constexpr size_t WS_CTL = 0, CTL_BYTES = 1 * MiB;
constexpr size_t CTL_USED = 96 * 1024;
constexpr size_t WS_MOD = 1 * MiB;
constexpr int MOD_G = 5, MOD_GS = 8 * 3072;
constexpr size_t WS_BIAS1 = 1 * MiB + 512 * 1024;
constexpr size_t WS_ROWSS = 2 * MiB;
constexpr size_t WS_COSR = 4 * MiB, WS_SINR = 8 * MiB;
constexpr size_t WS_COSN = 12 * MiB, WS_SINN = 13 * MiB;
constexpr size_t WS_WIN_T = 16 * MiB;
constexpr size_t WS_WOUT_T = 24 * MiB;
constexpr size_t WS_W1K_T = 26 * MiB, WS_W1V_T = 27 * MiB;
constexpr size_t WS_W2K_T = 28 * MiB, WS_W2V_T = 28 * MiB + 64 * 1024;
constexpr size_t WS_KCMP = 29 * MiB, WS_VCMP = 29 * MiB + 512 * 1024;
constexpr size_t WS_HID = 30 * MiB;
constexpr size_t WS_NGL = 34 * MiB;
constexpr size_t WS_H = 64 * MiB;
constexpr size_t WS_RQ = 128 * MiB, WS_RK = 160 * MiB, WS_RV = 192 * MiB, WS_RG = 224 * MiB, WS_NQ = 256 * MiB, WS_NG = 288 * MiB;
constexpr size_t WS_KV6 = 320 * MiB;
constexpr size_t KV6_STRIDE = 8 * MiB;
constexpr size_t WS_OWIN = 368 * MiB;
constexpr size_t WS_Z = 400 * MiB;
constexpr size_t WS_END = 464 * MiB;
constexpr int CW_Q3 = 8192, CW_Q4 = 8192 + 512;

constexpr int LDS_BYTES = 147456;
constexpr int XO_P = 131072 + 4096, XO_S = XO_P + 4096, XO_FLAG = XO_S + 1024;
constexpr size_t WS_GG = 1 * MiB + 768 * 1024;
constexpr int CW_KB = 3584;
constexpr int CW_PANEL = 12288;

struct Params {
  const float *x, *c; const int* pos; const float *w_ada, *b_ada, *g_pre, *g_post, *w_in, *w_out, *pe_k, *w1_k, *w2_k, *pe_v, *w1_v, *w2_v;
  float* out; unsigned char* ws;
  int ph_lo, ph_hi;
};

__device__ __forceinline__ unsigned pk2(float lo, float hi) { f32x2 v = {lo, hi}; bf16x2_t b = __builtin_convertvector(v, bf16x2_t); return __builtin_bit_cast(unsigned, b); }
__device__ __forceinline__ bf16_t f2bf(float f) { return (bf16_t)(pk2(f, 0.f) & 0xffffu); }
__device__ __forceinline__ float bf2f(unsigned short u) { return __uint_as_float(((unsigned)u) << 16); }
__device__ __forceinline__ float bflo(unsigned u) { return __uint_as_float(u << 16); }
__device__ __forceinline__ float bfhi(unsigned u) { return __uint_as_float(u & 0xffff0000u); }
__device__ __forceinline__ float fexp2(float x) { return __builtin_amdgcn_exp2f(x); }
__device__ __forceinline__ float siluf(float v) { return v * __builtin_amdgcn_rcpf(1.f + fexp2(-v * LOG2E)); }
__device__ __forceinline__ float sigmoidf(float v) { return __builtin_amdgcn_rcpf(1.f + fexp2(-v * LOG2E)); }
__device__ __forceinline__ float wave_sum(float v) {
#pragma unroll
  for (int o = 1; o < 64; o <<= 1) v += __shfl_xor(v, o);
  return v;
}
__device__ __forceinline__ s16x4 tr16(const LAS unsigned char* p) {
  typedef short v4i16_t __attribute__((ext_vector_type(4)));
  return __builtin_bit_cast(s16x4, __builtin_amdgcn_ds_read_tr16_b64_v4i16((LAS v4i16_t*)p));
}
__device__ __forceinline__ bf16x8 cat8(s16x4 a, s16x4 b) { return (bf16x8){a[0], a[1], a[2], a[3], b[0], b[1], b[2], b[3]}; }
#define MFMA16(a, b, c) __builtin_amdgcn_mfma_f32_16x16x32_bf16((a), (b), (c), 0, 0, 0)
#define MFMA32(a, b, c) __builtin_amdgcn_mfma_f32_32x32x16_bf16((a), (b), (c), 0, 0, 0)

__device__ __forceinline__ int retperm(int v) { const int j = v >> 3, i = v & 7; return (i < 4) ? 4 * j + i : 32 + 4 * j + (i - 4); }
__device__ __forceinline__ int nsaperm(int v) { const int j = v >> 3, i = v & 7; return (j < 2) ? ((i < 4) ? 4 * j + i : 8 + 4 * j + (i - 4)) : v; }
__device__ __forceinline__ int win_actual(int n) {
  const int pn = n >> 8, o = n & 255;
  if (pn < 8) { const int reg = pn >> 1, cr = (pn & 1) * 256 + o, head = cr >> 6, v = cr & 63; const int d = (pn < 4) ? retperm(v) : v; return reg * 512 + head * 64 + d; }
  if (pn < 10) { const int cr = (pn - 8) * 256 + o, head = cr >> 6, v = cr & 63; return 2048 + head * 64 + nsaperm(v); }
  if (pn < 13) { const int i6 = 2 * (pn - 10) + (o >> 7), w = o & 127, g = w >> 6, v = w & 63; const int d = (i6 == 2 || i6 == 4) ? nsaperm(v) : v; return 2560 + i6 * 128 + g * 64 + d; }
  if (pn < 15) return 3352 + (pn - 13) * 256 + o;
  return (o < 24) ? 3328 + o : -1;
}

#ifndef WGM_P2
#define WGM_P2 4
#endif
#ifndef WGM_P5
#define WGM_P5 8
#endif
namespace pg8 {
constexpr int BM = 256, BK = 64, HALF = 128, HTB = HALF * BK * 2, STAGE_BYTES = 8 * HTB, NXCD = 8;
__host__ __device__ __forceinline__ int lds_byte(int r, int c) { const int st = (r >> 4) * 2 + (c >> 5), rr = r & 15, cc = c & 31, ob = rr * 64 + cc * 2; return st * 1024 + (ob ^ (((ob >> 9) & 1) << 5)); }
__host__ __device__ __forceinline__ void stage_rc(int b, int& R, int& C) { const int st = b / 1024, sb = b % 1024, swz = sb ^ (((sb >> 9) & 1) << 5); R = (st >> 1) * 16 + swz / 64; C = (st & 1) * 32 + (swz % 64) / 2; }
__host__ __device__ __forceinline__ int perm32(int rho) { const int n = rho >> 4, i = rho & 15; return 8 * (i >> 2) + 4 * n + (i & 3); }
struct Unit { int pm, pn; };
struct Gemm { const bf16_t* A; const bf16_t* Bt; int M, N, K, lda, kstepA, ldb; };
struct StaticOrder {
  int nM, nN, nwg, G, c, WGM;
  __device__ void init(int M, int N, int G_, int c_, int wgm) { nM = M / BM; nN = N / BM; nwg = nM * nN; G = G_; c = c_; WGM = wgm; }
  __device__ bool next(int i, Unit& u) const {
    const long L = (long)i * G + c; if (L >= nwg) return false;
    int wgid = (int)L; { const int q = nwg / NXCD, r = nwg % NXCD, xcd = wgid % NXCD, off = wgid / NXCD; wgid = (xcd < r ? xcd * (q + 1) : r * (q + 1) + (xcd - r) * q) + off; }
    const int nig = WGM * nN, gid = wgid / nig, fm = gid * WGM, gsz = (nM - fm) < WGM ? (nM - fm) : WGM;
    u.pm = fm + ((wgid % nig) % gsz); u.pn = (wgid % nig) / gsz; return true;
  }
};
struct OneUnit { int valid; __device__ bool next(int i, Unit& u) const { if (i > 0 || !valid) return false; u.pm = 0; u.pn = 0; return true; } };

template <class Epi, class Sched>
__device__ __forceinline__ void gemm_phase(LAS unsigned char* lds, const Gemm g, const Sched& S, const Epi& E) {
  int tid_ = threadIdx.x; asm volatile("" : "+v"(tid_));
  const int tid = tid_, wid = __builtin_amdgcn_readfirstlane(tid >> 6), lane = tid & 63, wr = wid >> 2, wc = wid & 3, fr = lane & 15, fq = lane >> 4;
  const int K = g.K, nt = K / BK;
  unsigned voffA[2], voffB[2];
#pragma unroll
  for (int i = 0; i < 2; ++i) { int R, C; stage_rc(tid * 16 + i * 8192, R, C); const int Rb = (R & ~31) + perm32(R & 31);
    voffA[i] = (unsigned)(R * g.lda + C) * 2u; voffB[i] = (unsigned)(Rb * g.ldb + C) * 2u; }
  const size_t kstepB = (size_t)(BK * 2), kstepA = (size_t)g.kstepA;
  const size_t hstepB = (size_t)HALF * g.ldb * 2, hstepA = (size_t)HALF * g.lda * 2;
  const size_t tstepB = 2 * hstepB, tstepA = 2 * hstepA;
  const unsigned ldsw = (unsigned)wid * 1024u;
  const int aoff = lds_byte(wr * 64 + fr, fq * 8), boff = lds_byte(wc * 32 + fr, fq * 8);
#define PG8_SA(b, h) (((b) * 2 + (h)) * HTB)
#define PG8_SB(b, h) ((4 + (b) * 2 + (h)) * HTB)
#define PG8_STAGE(bufoff, gbase, voff) do { _Pragma("unroll") for (int _i = 0; _i < 2; ++_i) \
    __builtin_amdgcn_global_load_lds((const unsigned*)((const char*)(gbase) + (voff)[_i]), (LAS unsigned*)(lds + (bufoff) + ldsw + _i * 8192), 16, 0, 0); } while (0)
#define PG8_LDA(dst, b, h) do { _Pragma("unroll") for (int m = 0; m < 4; ++m) _Pragma("unroll") for (int k = 0; k < 2; ++k) dst[m][k] = *(const LAS bf16x8*)(lds + PG8_SA(b, h) + aoff + m * 2048 + k * 1024); } while (0)
#define PG8_LDB(dst, b, h) do { _Pragma("unroll") for (int n = 0; n < 2; ++n) _Pragma("unroll") for (int k = 0; k < 2; ++k) dst[n][k] = *(const LAS bf16x8*)(lds + PG8_SB(b, h) + boff + n * 2048 + k * 1024); } while (0)
#define PG8_MMA(ai, bj, At, Bt) do { __builtin_amdgcn_s_setprio(1); _Pragma("unroll") for (int m = 0; m < 4; ++m) _Pragma("unroll") for (int n = 0; n < 2; ++n) _Pragma("unroll") for (int k = 0; k < 2; ++k) \
    acc[ai][bj][m][n] = __builtin_amdgcn_mfma_f32_16x16x32_bf16(Bt[n][k], At[m][k], acc[ai][bj][m][n], 0, 0, 0); __builtin_amdgcn_s_setprio(0); } while (0)
#define PG8_WAIT_V(n) asm volatile("s_waitcnt vmcnt(" #n ")" ::: "memory")
#define PG8_WAIT_L(n) asm volatile("s_waitcnt lgkmcnt(" #n ")" ::: "memory")
#define PG8_BAR __builtin_amdgcn_s_barrier()
#define PG8_SCHED __builtin_amdgcn_sched_barrier(0)
  Unit cur, nxt; int ui = 0;
  if (!S.next(0, cur)) return;
  f32x4 acc[2][2][4][2];
#pragma unroll
  for (int a = 0; a < 2; ++a)
#pragma unroll
    for (int b = 0; b < 2; ++b)
#pragma unroll
      for (int m = 0; m < 4; ++m)
#pragma unroll
        for (int n = 0; n < 2; ++n) acc[a][b][m][n] = (f32x4){0.f, 0.f, 0.f, 0.f};
  bf16x8 At[4][2], B0[2][2], B1[2][2];
  const char* cA = (const char*)g.A + (size_t)cur.pm * tstepA; const char* cB = (const char*)g.Bt + (size_t)cur.pn * tstepB;
  PG8_STAGE(PG8_SB(0, 0), cB, voffB); PG8_STAGE(PG8_SB(0, 1), cB + hstepB, voffB); PG8_STAGE(PG8_SA(0, 0), cA, voffA); PG8_STAGE(PG8_SA(0, 1), cA + hstepA, voffA);
  if (wr == 1) PG8_BAR;
  PG8_WAIT_V(2); PG8_BAR;
  PG8_STAGE(PG8_SB(1, 0), cB + kstepB, voffB); PG8_STAGE(PG8_SA(1, 0), cA + kstepA, voffA); PG8_STAGE(PG8_SB(1, 1), cB + hstepB + kstepB, voffB);
  PG8_WAIT_V(6); PG8_BAR;
  for (;;) {
    const bool has_next = S.next(ui + 1, nxt);
    const char* nA = has_next ? (const char*)g.A + (size_t)nxt.pm * tstepA : cA; const char* nB = has_next ? (const char*)g.Bt + (size_t)nxt.pn * tstepB : cB;
    for (int t = 0; t < nt; t += 2) {
      const bool last = (t == nt - 2);
      const char* a1 = cA + (size_t)(t + 1) * kstepA;
      const char* a2 = last ? nA : cA + (size_t)(t + 2) * kstepA; const char* b2 = last ? nB : cB + (size_t)(t + 2) * kstepB;
      const char* a3 = a2 + kstepA; const char* b3 = b2 + kstepB;
      PG8_LDB(B0, 0, 0); PG8_LDB(B1, 0, 1); PG8_SCHED; PG8_LDA(At, 0, 0); PG8_STAGE(PG8_SA(1, 1), a1 + hstepA, voffA);
      PG8_WAIT_V(8); PG8_WAIT_L(0); PG8_BAR; PG8_MMA(0, 0, At, B0); PG8_MMA(0, 1, At, B1); PG8_BAR; PG8_SCHED;
      PG8_LDA(At, 0, 1); PG8_STAGE(PG8_SB(0, 0), b2, voffB); PG8_STAGE(PG8_SB(0, 1), b2 + hstepB, voffB); PG8_STAGE(PG8_SA(0, 0), a2, voffA);
      PG8_WAIT_V(8); PG8_WAIT_L(0); PG8_BAR; PG8_MMA(1, 0, At, B0); PG8_MMA(1, 1, At, B1); PG8_BAR; PG8_SCHED;
      PG8_LDB(B0, 1, 0); PG8_LDB(B1, 1, 1); PG8_SCHED; PG8_LDA(At, 1, 0); PG8_STAGE(PG8_SA(0, 1), a2 + hstepA, voffA);
      PG8_WAIT_V(8); PG8_WAIT_L(0); PG8_BAR; PG8_MMA(0, 0, At, B0); PG8_MMA(0, 1, At, B1); PG8_BAR; PG8_SCHED;
      PG8_LDA(At, 1, 1); PG8_STAGE(PG8_SB(1, 0), b3, voffB); PG8_STAGE(PG8_SB(1, 1), b3 + hstepB, voffB); PG8_STAGE(PG8_SA(1, 0), a3, voffA);
      PG8_WAIT_V(8); PG8_WAIT_L(0); PG8_BAR; PG8_MMA(1, 0, At, B0); PG8_MMA(1, 1, At, B1); PG8_BAR; PG8_SCHED;
    }
    if (wr == 0) PG8_BAR;
    E(acc, cur, wr, wc, fr, fq);
    if (!has_next) break;
#pragma unroll
    for (int a = 0; a < 2; ++a)
#pragma unroll
      for (int b = 0; b < 2; ++b)
#pragma unroll
        for (int m = 0; m < 4; ++m)
#pragma unroll
          for (int n = 0; n < 2; ++n) acc[a][b][m][n] = (f32x4){0.f, 0.f, 0.f, 0.f};
    cur = nxt; cA = nA; cB = nB; ++ui;
    if (wr == 1) PG8_BAR;
  }
  PG8_WAIT_V(0);
  PG8_BAR;
#undef PG8_SA
#undef PG8_SB
#undef PG8_STAGE
#undef PG8_LDA
#undef PG8_LDB
#undef PG8_MMA
#undef PG8_WAIT_V
#undef PG8_WAIT_L
#undef PG8_BAR
#undef PG8_SCHED
}
}

struct EpiProj {
  unsigned char* ws;
  template <int M0, int M1, bool TRK>
  __device__ __forceinline__ void body(const f32x4 (&acc)[2][2][4][2], bf16_t* base0, bf16_t* base1, int ld, float sc, bool st0, bool st1, int row0, int cw, int j, unsigned* kbw) const {
    const float* cosr = (const float*)(ws + WS_COSR); const float* sinr = (const float*)(ws + WS_SINR);
    const float* cosn = (const float*)(ws + WS_COSN); const float* sinn = (const float*)(ws + WS_SINN);
    float kmx = 0.f;
#pragma unroll
    for (int ai = 0; ai < 2; ++ai)
#pragma unroll
      for (int m = 0; m < 4; ++m) {
        const int row = row0 + ai * 128 + m * 16;
        f32x4 cs = {1.f, 1.f, 1.f, 1.f}, sn = {0.f, 0.f, 0.f, 0.f};
        if (M0 == 1) { cs = *(const f32x4*)(cosr + (size_t)row * 32 + 4 * j); sn = *(const f32x4*)(sinr + (size_t)row * 32 + 4 * j); }
        else if (M0 == 2) { if (j < 2) { cs = *(const f32x4*)(cosn + (size_t)row * 8 + 4 * j); sn = *(const f32x4*)(sinn + (size_t)row * 8 + 4 * j); } }
#pragma unroll
        for (int bj = 0; bj < 2; ++bj) {
          const int mode = bj ? M1 : M0;
          f32x4 v0 = acc[ai][bj][m][0], v1 = acc[ai][bj][m][1];
          if (mode != 0) { const f32x4 a = v0 * cs - v1 * sn, b = v0 * sn + v1 * cs; v0 = a; v1 = b; }
          v0 = v0 * sc; v1 = v1 * sc;
          u32x4 w; w.x = pk2(v0[0], v0[1]); w.y = pk2(v0[2], v0[3]); w.z = pk2(v1[0], v1[1]); w.w = pk2(v1[2], v1[3]);
          bf16_t* bp = bj ? base1 : base0;
          if (bj ? st1 : st0) *(u32x4*)(bp + (size_t)row * ld + cw) = w;
          if (TRK && bj == 0) {
            float ss = ((v0[0] * v0[0] + v0[1] * v0[1]) + (v0[2] * v0[2] + v0[3] * v0[3])) + ((v1[0] * v1[0] + v1[1] * v1[1]) + (v1[2] * v1[2] + v1[3] * v1[3]));
            ss += __shfl_xor(ss, 16); ss += __shfl_xor(ss, 32);
            kmx = fmaxf(kmx, ss);
          }
        }
      }
    if (TRK) {
#pragma unroll
      for (int o = 1; o < 16; o <<= 1) kmx = fmaxf(kmx, __shfl_xor(kmx, o));
      if ((threadIdx.x & 63) == 0) atomicMax(kbw, __float_as_uint(kmx));
    }
  }
  __device__ __forceinline__ void operator()(const f32x4 (&acc)[2][2][4][2], const pg8::Unit& u, int wr, int wc, int fr, int fq) const {
    const int pn = u.pn;
    const int row0 = u.pm * 256 + wr * 64 + fr;
    const int cw = wc * 32 + 8 * fq;
    const int j = 4 * (wc & 1) + fq;
    if (pn < 4) { bf16_t* bp = (bf16_t*)(ws + WS_RQ + (size_t)(pn >> 1) * 32 * MiB) + (pn & 1) * 256; body<1, 1, false>(acc, bp, bp + 128, 512, (pn < 2) ? 0.125f : 1.f, true, true, row0, cw, j, nullptr); }
    else if (pn < 8) { bf16_t* bp = (bf16_t*)(ws + WS_RQ + (size_t)(pn >> 1) * 32 * MiB) + (pn & 1) * 256; body<0, 0, false>(acc, bp, bp + 128, 512, 1.f, true, true, row0, cw, j, nullptr); }
    else if (pn < 10) { bf16_t* bp = (bf16_t*)(ws + WS_NQ) + (pn - 8) * 256; body<2, 2, false>(acc, bp, bp + 128, 512, 0.125f * LOG2E, true, true, row0, cw, j, nullptr); }
    else if (pn < 13) {
      const int i6 = 2 * (pn - 10); bf16_t* b0 = (bf16_t*)(ws + WS_KV6 + (size_t)i6 * KV6_STRIDE); bf16_t* b1 = (bf16_t*)(ws + WS_KV6 + (size_t)(i6 + 1) * KV6_STRIDE);
      if (pn == 10) body<0, 0, false>(acc, b0, b1, 128, 1.f, true, true, row0, cw, j, nullptr);
      else body<2, 0, true>(acc, b0, b1, 128, 1.f, true, true, row0, cw, j, (unsigned*)(ws + WS_CTL) + CW_KB + (((pn - 11) * 16 + (u.pm >> 4) * 2 + (wc >> 1)) * 2 + (wc & 1)));
    }
    else if (pn < 15) { bf16_t* bp = (bf16_t*)(ws + WS_NG) + (pn - 13) * 256; body<0, 0, false>(acc, bp, bp + 128, 512, 1.f, true, true, row0, cw, j, nullptr); }
    else { bf16_t* bp = (bf16_t*)(ws + WS_NGL); body<0, 0, false>(acc, bp, bp, 32, 1.f, (wc == 0 && fq < 4), false, row0, cw, j, nullptr); }
  }
};
struct EpiZ {
  bf16_t* Z; float* rowss;
  __device__ __forceinline__ void operator()(const f32x4 (&acc)[2][2][4][2], const pg8::Unit& u, int wr, int wc, int fr, int fq) const {
    const int row0 = u.pm * 256 + wr * 64 + fr, col0 = u.pn * 256 + wc * 32 + 8 * fq;
#pragma unroll
    for (int ai = 0; ai < 2; ++ai)
#pragma unroll
      for (int m = 0; m < 4; ++m) {
        const int row = row0 + ai * 128 + m * 16; float ss = 0.f;
#pragma unroll
        for (int bj = 0; bj < 2; ++bj) {
          const f32x4 v0 = acc[ai][bj][m][0], v1 = acc[ai][bj][m][1];
          ss += (v0[0] * v0[0] + v0[1] * v0[1]) + (v0[2] * v0[2] + v0[3] * v0[3]) + (v1[0] * v1[0] + v1[1] * v1[1]) + (v1[2] * v1[2] + v1[3] * v1[3]);
          u32x4 w; w.x = pk2(v0[0], v0[1]); w.y = pk2(v0[2], v0[3]); w.z = pk2(v1[0], v1[1]); w.w = pk2(v1[2], v1[3]);
          *(u32x4*)(Z + (size_t)row * DM + col0 + bj * 128) = w;
        }
      }
  }
};
#ifndef XNE
#define XNE 8
#endif
struct EpiOut {
  const float* x; float* out; const float* gg; float* xbuf; unsigned* cnt; LAS unsigned char* lds;
  __device__ __forceinline__ void operator()(const f32x4 (&acc)[2][2][4][2], const pg8::Unit& u, int wr, int wc, int fr, int fq) const {
    const int tid = threadIdx.x, lane = tid & 63, wid = tid >> 6;
    LAS float* P = (LAS float*)(lds + XO_P); LAS float* S = (LAS float*)(lds + XO_S); LAS unsigned* flag = (LAS unsigned*)(lds + XO_FLAG);
    u32x2 zp[2][2][4][2];
#pragma unroll
    for (int ai = 0; ai < 2; ++ai)
#pragma unroll
      for (int m = 0; m < 4; ++m) {
        float ss = 0.f;
#pragma unroll
        for (int bj = 0; bj < 2; ++bj) { const f32x4 v0 = acc[ai][bj][m][0], v1 = acc[ai][bj][m][1];
          ss += (v0[0] * v0[0] + v0[1] * v0[1]) + (v0[2] * v0[2] + v0[3] * v0[3]) + (v1[0] * v1[0] + v1[1] * v1[1]) + (v1[2] * v1[2] + v1[3] * v1[3]);
          zp[ai][bj][m][0] = (u32x2){pk2(v0[0], v0[1]), pk2(v0[2], v0[3])}; zp[ai][bj][m][1] = (u32x2){pk2(v1[0], v1[1]), pk2(v1[2], v1[3])};
          asm volatile("" : "+v"(zp[ai][bj][m][0]), "+v"(zp[ai][bj][m][1])); }
        ss += __shfl_xor(ss, 16); ss += __shfl_xor(ss, 32);
        if (fq == 0) P[(ai * 128 + wr * 64 + m * 16 + fr) * 4 + wc] = ss;
      }
    __syncthreads();
    if (tid < 256) { const float t = (P[tid * 4] + P[tid * 4 + 1]) + (P[tid * 4 + 2] + P[tid * 4 + 3]);
      __hip_atomic_store(xbuf + ((size_t)u.pm * 256 + tid) * 4 + u.pn, t, __ATOMIC_RELAXED, __HIP_MEMORY_SCOPE_AGENT); }
    asm volatile("s_waitcnt vmcnt(0)" ::: "memory");
    if (wid < 4 && lane == 0) __hip_atomic_fetch_add(cnt + 64 * u.pm, 1u, __ATOMIC_RELAXED, __HIP_MEMORY_SCOPE_AGENT);
    const int b = u.pm >> 4; const int col0 = u.pn * 256 + wc * 32 + 8 * fq;
    constexpr int NE = XNE;
    f32x4 xv[NE][4];
    const float* xt = x + ((size_t)u.pm * 256 + wr * 64) * DM; float* ot = out + ((size_t)u.pm * 256 + wr * 64) * DM;
    const unsigned lo = (unsigned)(fr * DM + col0);
#pragma unroll
    for (int it = 0; it < NE; ++it) {
      const float* xr = xt + (size_t)((it >> 2) * 128 + (it & 3) * 16) * DM;
      xv[it][0] = *(const f32x4*)(xr + lo); xv[it][1] = *(const f32x4*)(xr + lo + 4); xv[it][2] = *(const f32x4*)(xr + lo + 128); xv[it][3] = *(const f32x4*)(xr + lo + 132);
    }
    if (wid == 0) {
      unsigned sp = 0;
      while ((unsigned)__builtin_amdgcn_readfirstlane(__hip_atomic_load(cnt + 64 * u.pm, __ATOMIC_RELAXED, __HIP_MEMORY_SCOPE_AGENT)) < 16u && ++sp < (1u << 22)) __builtin_amdgcn_s_sleep(2);
      __builtin_amdgcn_fence(__ATOMIC_ACQUIRE, "agent");
    }
    __syncthreads();
    if (tid < 256) { const float* xb = xbuf + ((size_t)u.pm * 256 + tid) * 4; float t = 0.f;
#pragma unroll
      for (int q = 0; q < 4; ++q) t += __hip_atomic_load(xb + q, __ATOMIC_RELAXED, __HIP_MEMORY_SCOPE_AGENT);
      S[tid] = __builtin_amdgcn_rsqf(t * (1.f / DM) + 1e-6f); }
    __syncthreads();
    const f32x4 g00 = *(const f32x4*)(gg + b * 1024 + col0), g01 = *(const f32x4*)(gg + b * 1024 + col0 + 4), g10 = *(const f32x4*)(gg + b * 1024 + col0 + 128), g11 = *(const f32x4*)(gg + b * 1024 + col0 + 132);
#define ZU(Z_) (f32x4){bflo((Z_).x), bfhi((Z_).x), bflo((Z_).y), bfhi((Z_).y)}
#pragma unroll
    for (int ai = 0; ai < 2; ++ai)
#pragma unroll
      for (int m = 0; m < 4; ++m) {
        const int rl = ai * 128 + wr * 64 + m * 16 + fr; const float r = S[rl];
        const int it = ai * 4 + m;
        const float* xr = xt + (size_t)(ai * 128 + m * 16) * DM; float* orw = ot + (size_t)(ai * 128 + m * 16) * DM;
        f32x4 x0, x1, x2, x3;
        if (it < NE) { x0 = xv[it < NE ? it : 0][0]; x1 = xv[it < NE ? it : 0][1]; x2 = xv[it < NE ? it : 0][2]; x3 = xv[it < NE ? it : 0][3]; }
        else { x0 = *(const f32x4*)(xr + lo); x1 = *(const f32x4*)(xr + lo + 4); x2 = *(const f32x4*)(xr + lo + 128); x3 = *(const f32x4*)(xr + lo + 132); }
        *(f32x4*)(orw + lo) = x0 + g00 * (ZU(zp[ai][0][m][0]) * r); *(f32x4*)(orw + lo + 4) = x1 + g01 * (ZU(zp[ai][0][m][1]) * r);
        *(f32x4*)(orw + lo + 128) = x2 + g10 * (ZU(zp[ai][1][m][0]) * r); *(f32x4*)(orw + lo + 132) = x3 + g11 * (ZU(zp[ai][1][m][1]) * r);
      }
#undef ZU
    __syncthreads();
  }
};
struct EpiPart {
  float* P; unsigned* flag;
  __device__ __forceinline__ void operator()(const f32x4 (&acc)[2][2][4][2], const pg8::Unit& u, int wr, int wc, int fr, int fq) const {
    const int row0 = wr * 64 + fr, col0 = wc * 32 + 8 * fq;
#pragma unroll
    for (int ai = 0; ai < 2; ++ai)
#pragma unroll
      for (int m = 0; m < 4; ++m) {
        const int row = row0 + ai * 128 + m * 16;
#pragma unroll
        for (int bj = 0; bj < 2; ++bj) { *(f32x4*)(P + (size_t)row * 256 + col0 + bj * 128) = acc[ai][bj][m][0]; *(f32x4*)(P + (size_t)row * 256 + col0 + bj * 128 + 4) = acc[ai][bj][m][1]; }
      }
    asm volatile("s_waitcnt vmcnt(0)" ::: "memory"); __builtin_amdgcn_fence(__ATOMIC_RELEASE, "agent"); __syncthreads();
    if (threadIdx.x == 0) __hip_atomic_store(flag, 1u, __ATOMIC_RELAXED, __HIP_MEMORY_SCOPE_AGENT);
  }
};
struct EpiHid {
  bf16_t* O; const float* bias; const float* P; unsigned* flag;
  __device__ __forceinline__ void operator()(const f32x4 (&acc)[2][2][4][2], const pg8::Unit& u, int wr, int wc, int fr, int fq) const {
    if (threadIdx.x == 0) { unsigned sp = 0; while (__hip_atomic_load(flag, __ATOMIC_RELAXED, __HIP_MEMORY_SCOPE_AGENT) == 0u && ++sp < (1u << 22)) __builtin_amdgcn_s_sleep(2); }
    __syncthreads(); __builtin_amdgcn_fence(__ATOMIC_ACQUIRE, "agent");
    const int row0 = wr * 64 + fr, col0 = wc * 32 + 8 * fq;
#pragma unroll
    for (int ai = 0; ai < 2; ++ai)
#pragma unroll
      for (int m = 0; m < 4; ++m) {
        const int row = row0 + ai * 128 + m * 16;
#pragma unroll
        for (int bj = 0; bj < 2; ++bj) {
          const f32x4 b0 = *(const f32x4*)(bias + col0 + bj * 128), b1 = *(const f32x4*)(bias + col0 + bj * 128 + 4);
          const f32x4 q0 = *(const f32x4*)(P + (size_t)row * 256 + col0 + bj * 128), q1 = *(const f32x4*)(P + (size_t)row * 256 + col0 + bj * 128 + 4);
          const f32x4 v0 = acc[ai][bj][m][0] + b0 + q0, v1 = acc[ai][bj][m][1] + b1 + q1;
          u32x4 w; w.x = pk2(siluf(v0[0]), siluf(v0[1])); w.y = pk2(siluf(v0[2]), siluf(v0[3])); w.z = pk2(siluf(v1[0]), siluf(v1[1])); w.w = pk2(siluf(v1[2]), siluf(v1[3]));
          *(u32x4*)(O + (size_t)row * 256 + col0 + bj * 128) = w;
        }
      }
  }
};
struct EpiHidSolo {
  bf16_t* O; const float* bias; const float* P; unsigned* flag;
  __device__ __forceinline__ void operator()(const f32x4 (&acc)[2][2][4][2], const pg8::Unit& u, int wr, int wc, int fr, int fq) const {
    const int row0 = wr * 64 + fr, col0 = wc * 32 + 8 * fq;
#pragma unroll
    for (int ai = 0; ai < 2; ++ai)
#pragma unroll
      for (int m = 0; m < 4; ++m) {
        const int row = row0 + ai * 128 + m * 16;
#pragma unroll
        for (int bj = 0; bj < 2; ++bj) {
          const f32x4 b0 = *(const f32x4*)(bias + col0 + bj * 128), b1 = *(const f32x4*)(bias + col0 + bj * 128 + 4);
          const f32x4 v0 = acc[ai][bj][m][0] + b0, v1 = acc[ai][bj][m][1] + b1;
          u32x4 w; w.x = pk2(siluf(v0[0]), siluf(v0[1])); w.y = pk2(siluf(v0[2]), siluf(v0[3])); w.z = pk2(siluf(v1[0]), siluf(v1[1])); w.w = pk2(siluf(v1[2]), siluf(v1[3]));
          *(u32x4*)(O + (size_t)row * 256 + col0 + bj * 128) = w;
        }
      }
  }
};

template <int MAP>
__device__ __forceinline__ void transpose_item(const float* W, int K, int ldw, bf16_t* WT, LAS float* scr, int nblk, int item, int lane) {
  const int kb = item / nblk, nb = item % nblk, k0 = 64 * kb, n0 = 32 * nb;
  const int nsrc = MAP ? win_actual(n0 + (lane & 31)) : n0 + (lane & 31);
  float wv[32];
#pragma unroll
  for (int i = 0; i < 32; ++i) { const int kk = 2 * i + (lane >> 5); wv[i] = (nsrc >= 0) ? W[(size_t)(k0 + kk) * ldw + nsrc] : 0.f; }
#pragma unroll
  for (int i = 0; i < 32; ++i) { const int kk = 2 * i + (lane >> 5); scr[kk * 33 + (lane & 31)] = wv[i]; }
  asm volatile("s_waitcnt lgkmcnt(0)" ::: "memory");
  const int c = lane & 7;
#pragma unroll
  for (int jj = 0; jj < 4; ++jj) { const int n = (lane >> 3) + 8 * jj; const LAS float* s = scr + (8 * c) * 33 + n;
    u32x4 o; o.x = pk2(s[0 * 33], s[1 * 33]); o.y = pk2(s[2 * 33], s[3 * 33]); o.z = pk2(s[4 * 33], s[5 * 33]); o.w = pk2(s[6 * 33], s[7 * 33]);
    *(u32x4*)(WT + (size_t)(n0 + n) * K + k0 + 8 * c) = o; }
  asm volatile("s_waitcnt lgkmcnt(0)" ::: "memory");
}

__device__ __forceinline__ void phase0(const Params& p, LAS unsigned char* lds) {
  int tid_ = threadIdx.x; asm volatile("" : "+v"(tid_));
  const int tid = tid_, lane = tid & 63, wave = __builtin_amdgcn_readfirstlane(tid >> 6);
  const int bid = blockIdx.x, G = gridDim.x;
  unsigned char* ws = p.ws;
  for (int item = bid; item < 48 * MOD_G; item += G) {
    const int slab = item % 48, kg = item / 48, k0 = kg * 205, k1 = (k0 + 205 < 1024) ? k0 + 205 : 1024;
    LAS float* sc = (LAS float*)lds;
    LAS float* part = (LAS float*)(lds + 32768);
    const int col = slab * 64 + lane;
    float wv[26];
#pragma unroll
    for (int i = 0; i < 26; ++i) { const int k = k0 + wave + 8 * i; wv[i] = (k < k1) ? p.w_ada[(size_t)k * 3072 + col] : 0.f; }
    for (int i = tid; i < 8 * 1024; i += NTHREADS) sc[i] = siluf(p.c[i]);
    __syncthreads();
    float a[8] = {0.f, 0.f, 0.f, 0.f, 0.f, 0.f, 0.f, 0.f};
#pragma unroll
    for (int i = 0; i < 26; ++i) {
      const int k_ = k0 + wave + 8 * i, k = k_ < 1024 ? k_ : 1023;
#pragma unroll
      for (int b = 0; b < 8; ++b) a[b] += sc[b * 1024 + k] * wv[i];
    }
#pragma unroll
    for (int b = 0; b < 8; ++b) part[(wave * 8 + b) * 64 + lane] = a[b];
    __syncthreads();
    { const int b = tid >> 6; float sm = 0.f;
#pragma unroll
      for (int w = 0; w < 8; ++w) sm += part[(w * 8 + b) * 64 + lane];
      ((float*)(ws + WS_MOD))[kg * MOD_GS + b * 3072 + col] = sm; }
    __syncthreads();
  }
  for (int it = (bid + G - 240 % G) % G; it < 16; it += G) {
    const int kv = it >> 3, slab = it & 7, kh = lane >> 5; const float* pe = (kv ? p.pe_v : p.pe_k) + wave * 256 + kh * 128; const int col = slab * 32 + (lane & 31);
    const float* w1 = (kv ? p.w1_v : p.w1_k) + (size_t)(wave * 256 + kh * 128) * 256 + col;
    LAS float* part = (LAS float*)(lds + 65536);
    float a = 0.f;
#pragma unroll 1
    for (int k0 = 0; k0 < 128; k0 += 32) {
      float wv[32];
#pragma unroll
      for (int i = 0; i < 32; ++i) wv[i] = w1[(size_t)(k0 + i) * 256];
#pragma unroll
      for (int i = 0; i < 32; ++i) a += pe[k0 + i] * wv[i];
    }
    part[wave * 64 + lane] = a;
    __syncthreads();
    if (tid < 32) { float s = 0.f;
#pragma unroll
      for (int w = 0; w < 16; ++w) s += part[w * 32 + tid];
      ((float*)(ws + WS_BIAS1))[kv * 256 + slab * 32 + tid] = s; }
    __syncthreads();
  }
}

__device__ __forceinline__ void phase0b(const Params& p, LAS unsigned char* lds) {
  int tid_ = threadIdx.x; asm volatile("" : "+v"(tid_));
  const int tid = tid_, lane = tid & 63, wave = __builtin_amdgcn_readfirstlane(tid >> 6);
  const int bid = blockIdx.x, G = gridDim.x;
  unsigned char* ws = p.ws;
  {
    LAS float* scr = (LAS float*)(lds + wave * 8704);
    const int gw = ((bid + G - 56) % G) * NWAVES + wave, NGW = G * NWAVES;
    constexpr int I_IN = 16 * 128, I_OUT = 16 * 32, I_W1 = 32 * 8, I_W2 = 4 * 2;
    constexpr int NIT = I_IN + I_OUT + 2 * I_W1 + 2 * I_W2;
    for (int it = gw; it < NIT; it += NGW) {
      int r = it;
      if (r < I_IN) { transpose_item<1>(p.w_in, 1024, 3864, (bf16_t*)(ws + WS_WIN_T), scr, 128, r, lane); continue; } r -= I_IN;
      if (r < I_OUT) { transpose_item<0>(p.w_out, 1024, 1024, (bf16_t*)(ws + WS_WOUT_T), scr, 32, r, lane); continue; } r -= I_OUT;
      if (r < I_W1) { transpose_item<0>(p.w1_k, 2048, 256, (bf16_t*)(ws + WS_W1K_T), scr, 8, r, lane); continue; } r -= I_W1;
      if (r < I_W1) { transpose_item<0>(p.w1_v, 2048, 256, (bf16_t*)(ws + WS_W1V_T), scr, 8, r, lane); continue; } r -= I_W1;
      if (r < I_W2) { transpose_item<0>(p.w2_k, 256, 64, (bf16_t*)(ws + WS_W2K_T), scr, 2, r, lane); continue; } r -= I_W2;
      transpose_item<0>(p.w2_v, 256, 64, (bf16_t*)(ws + WS_W2V_T), scr, 2, r, lane);
    }
  }
  {
    const int gt = bid * NTHREADS + tid, GT = G * NTHREADS;
    if (gt < 8 * 1024) { const int b = gt >> 10, col = gt & 1023; float v = p.b_ada[2048 + col];
      for (int g = 0; g < MOD_G; ++g) v += ((const float*)(ws + WS_MOD))[g * MOD_GS + b * 3072 + 2048 + col];
      ((float*)(ws + WS_GG))[gt] = v * p.g_post[col]; }
    float* cosr = (float*)(ws + WS_COSR); float* sinr = (float*)(ws + WS_SINR); float* cosn = (float*)(ws + WS_COSN); float* sinn = (float*)(ws + WS_SINN);
#pragma unroll 5
    for (int i = gt; i < MTOK * 40; i += GT) {
      const int tok = i / 40, f = i % 40;
      const float posf = (float)p.pos[tok];
      float inv; if (f < 32) inv = fexp2(-(float)f * (13.287712379549449f / 32.f)); else inv = fexp2(-(float)(f - 32) * (18.931568569324174f / 8.f));
      const float ang = posf * inv;
      const double rev = (double)ang * 0.15915494309189535; const float fr = (float)(rev - __builtin_rint(rev));
      const float cv = __builtin_amdgcn_cosf(fr), sv = __builtin_amdgcn_sinf(fr);
      if (f < 32) { cosr[(size_t)tok * 32 + f] = cv; sinr[(size_t)tok * 32 + f] = sv; } else { cosn[(size_t)tok * 8 + f - 32] = cv; sinn[(size_t)tok * 8 + f - 32] = sv; }
    }
  }
}

__device__ __forceinline__ void mod_read16(const Params& p, int b, int col0, int lane, f32x4 (&v)[4]) {
  const float* ptr = (const float*)(p.ws + WS_MOD) + b * 3072 + col0 + 4 * lane;
#pragma unroll
  for (int j = 0; j < 4; ++j) v[j] = *(const f32x4*)(p.b_ada + col0 + 4 * lane + 256 * j);
#pragma unroll 1
  for (int g = 0; g < MOD_G; ++g) {
#pragma unroll
    for (int j = 0; j < 4; ++j) v[j] = v[j] + *(const f32x4*)(ptr + 256 * j);
    ptr += MOD_GS;
  }
}
__device__ __forceinline__ void phase1(const Params& p) {
  int tid_ = threadIdx.x; asm volatile("" : "+v"(tid_));
  const int tid = tid_, lane = tid & 63, wave = tid >> 6;
  const int gw = blockIdx.x * NWAVES + wave, NGW = gridDim.x * NWAVES;
  const float* mod = (const float*)(p.ws + WS_MOD);
  bf16_t* H = (bf16_t*)(p.ws + WS_H);
  constexpr int RPW = 16;
  for (int it = gw; it < MTOK / RPW; it += NGW) {
    const int wb = it >> 3, itp = 256 * (wb & 7) + 8 * ((wb >> 3) & 31) + (it & 7);
    const int row0 = itp * RPW, b = row0 / SEQ;
    f32x4 gs[4], sh[4];
    mod_read16(p, b, 1024, lane, gs); mod_read16(p, b, 0, lane, sh);
#pragma unroll
    for (int j = 0; j < 4; ++j) { const int k = 4 * lane + 256 * j; gs[j] = *(const f32x4*)(p.g_pre + k) * (gs[j] + 1.0f); }
    const f32x4* xb = (const f32x4*)(p.x + (size_t)row0 * DM) + lane;
    f32x4 va[4], vb[4], vc[4];
#define P1_LD(V, r) do { const int r_ = (r) < RPW ? (r) : RPW - 1; _Pragma("unroll") for (int j = 0; j < 4; ++j) V[j] = xb[(size_t)r_ * (DM / 4) + 64 * j]; } while (0)
#define P1_ROW(V, r) do { float s = 0.f; _Pragma("unroll") for (int j = 0; j < 4; ++j) s += (V[j].x * V[j].x + V[j].y * V[j].y) + (V[j].z * V[j].z + V[j].w * V[j].w); \
      const float rstd = __builtin_amdgcn_rsqf(wave_sum(s) * (1.f / DM) + 1e-6f); \
      u32x2* o8 = (u32x2*)(H + (size_t)(row0 + (r)) * DM) + lane; \
      _Pragma("unroll") for (int j = 0; j < 4; ++j) { const f32x4 hv = V[j] * rstd * gs[j] + sh[j]; u32x2 w; w.x = pk2(hv.x, hv.y); w.y = pk2(hv.z, hv.w); o8[64 * j] = w; } } while (0)
    P1_LD(va, 0); P1_LD(vb, 1);
    for (int r = 0; r < RPW; r += 3) {
      P1_LD(vc, r + 2); P1_ROW(va, r);
      if (r + 1 < RPW) { P1_LD(va, r + 3); P1_ROW(vb, r + 1); }
      if (r + 2 < RPW) { P1_LD(vb, r + 4); P1_ROW(vc, r + 2); }
    }
#undef P1_LD
#undef P1_ROW
  }
}

constexpr int RS = 144;
constexpr int PRS = 272;
constexpr int R_Q = 0, R_K = 128 * RS, R_KZ = 2 * 128 * RS, R_V = 3 * 128 * RS, R_P = 4 * 128 * RS, R_RT = R_P + 128 * PRS, R_END = R_RT + 64 * RS;
static_assert(R_END <= 131072, "ret LDS");
constexpr size_t WS_KVC = WS_Z, WS_RP = WS_Z + 32 * MiB, WS_PART = WS_Z + 48 * MiB;
constexpr int CW_CMPF = 3072;
constexpr int CW_RETCNT = 1024;
__device__ __forceinline__ float ret_l2g(int h) { const float xg = fexp2(-5.f - (float)h); return -LOG2E * (xg + xg * xg * 0.5f + xg * xg * xg * (1.f / 3.f) + xg * xg * xg * xg * 0.25f + xg * xg * xg * xg * xg * 0.2f); }
__device__ __forceinline__ void reta_unit(const Params& p, LAS unsigned char* lds, int bh) {
  int tid_ = threadIdx.x; asm volatile("" : "+v"(tid_));
  const int tid = tid_, lane = tid & 63, wave = __builtin_amdgcn_readfirstlane(tid >> 6);
  const int l15 = lane & 15, g4 = lane >> 4, tq = l15 >> 2, tp = l15 & 3;
  unsigned char* ws = p.ws; const int b = bh >> 3, h = bh & 7;
  const float l2g = ret_l2g(h); const float cdec = fexp2(128.f * l2g);
  const int row0 = tid >> 3, ch = tid & 7;
  const bf16_t* RKp = (const bf16_t*)(ws + WS_RK) + ((size_t)b * SEQ + row0) * 512 + h * 64 + ch * 8;
  const bf16_t* RVp = (const bf16_t*)(ws + WS_RV) + ((size_t)b * SEQ + row0) * 512 + h * 64 + ch * 8;
  const float z0 = fexp2((float)(127 - row0) * l2g), z1 = fexp2((float)(63 - row0) * l2g);
  bf16_t* RP = (bf16_t*)(ws + WS_RP) + (size_t)(bh * 32) * 4096;
  f32x4 racc[2] = {{0.f, 0.f, 0.f, 0.f}, {0.f, 0.f, 0.f, 0.f}};
  const int dt = wave >> 1, et0 = 2 * (wave & 1);
  constexpr int BUFB = 2 * 128 * RS;
#define RA_LOAD(K0, K1, V0, V1, n) do { const int n_ = (n) < 31 ? (n) : 30; const size_t o_ = (size_t)n_ * 128 * 512; \
    K0 = *(const u32x4*)(RKp + o_); K1 = *(const u32x4*)(RKp + o_ + 64 * 512); V0 = *(const u32x4*)(RVp + o_); V1 = *(const u32x4*)(RVp + o_ + 64 * 512); } while (0)
#define RA_KZ(KV_, ZS_) (u32x4){pk2(bflo((KV_).x) * (ZS_), bfhi((KV_).x) * (ZS_)), pk2(bflo((KV_).y) * (ZS_), bfhi((KV_).y) * (ZS_)), pk2(bflo((KV_).z) * (ZS_), bfhi((KV_).z) * (ZS_)), pk2(bflo((KV_).w) * (ZS_), bfhi((KV_).w) * (ZS_))}
#define RA_STEP(K0, K1, V0, V1, n) do { \
    LAS unsigned char* bf_ = lds + ((n) & 1) * BUFB; const int lo_ = row0 * RS + ch * 16; \
    *(LAS u32x4*)(bf_ + lo_) = RA_KZ(K0, z0); *(LAS u32x4*)(bf_ + lo_ + 64 * RS) = RA_KZ(K1, z1); \
    *(LAS u32x4*)(bf_ + 128 * RS + lo_) = V0; *(LAS u32x4*)(bf_ + 128 * RS + lo_ + 64 * RS) = V1; \
    RA_LOAD(K0, K1, V0, V1, (n) + 3); \
    __syncthreads(); \
    racc[0] = racc[0] * cdec; racc[1] = racc[1] * cdec; \
    _Pragma("unroll") for (int ks = 0; ks < 4; ++ks) { \
      const LAS unsigned char* ka = bf_ + (32 * ks + 8 * g4 + tq) * RS + (16 * dt + 4 * tp) * 2; \
      const bf16x8 af = cat8(tr16(ka), tr16(ka + 4 * RS)); \
      _Pragma("unroll") for (int t = 0; t < 2; ++t) { const LAS unsigned char* va = bf_ + 128 * RS + (32 * ks + 8 * g4 + tq) * RS + (16 * (et0 + t) + 4 * tp) * 2; \
        const bf16x8 bfr = cat8(tr16(va), tr16(va + 4 * RS)); racc[t] = MFMA16(af, bfr, racc[t]); } } \
    { bf16_t* dst_ = RP + (size_t)((n) + 1) * 4096; \
      _Pragma("unroll") for (int t = 0; t < 2; ++t) _Pragma("unroll") for (int r = 0; r < 4; ++r) dst_[(16 * dt + 4 * g4 + r) * 64 + 16 * (et0 + t) + l15] = f2bf(racc[t][r]); } \
  } while (0)
  u32x4 ka0, ka1, va0, va1, kb0, kb1, vb0, vb1, kc0, kc1, vc0, vc1;
  RA_LOAD(ka0, ka1, va0, va1, 0); RA_LOAD(kb0, kb1, vb0, vb1, 1); RA_LOAD(kc0, kc1, vc0, vc1, 2);
  for (int n = 0; n < 30; n += 3) { RA_STEP(ka0, ka1, va0, va1, n); RA_STEP(kb0, kb1, vb0, vb1, n + 1); RA_STEP(kc0, kc1, vc0, vc1, n + 2); }
  RA_STEP(ka0, ka1, va0, va1, 30);
#undef RA_LOAD
#undef RA_KZ
#undef RA_STEP
  __syncthreads();
}
constexpr int R_RG = R_KZ;
struct RbRegs { u32x4 q0, q1, k0, k1, v0, v1, g0, g1, r; };
__device__ __forceinline__ float row16_sum(float v) {
  v += __int_as_float(__builtin_amdgcn_mov_dpp(__float_as_int(v), 0xB1, 0xF, 0xF, true));
  v += __int_as_float(__builtin_amdgcn_mov_dpp(__float_as_int(v), 0x4E, 0xF, 0xF, true));
  v += __int_as_float(__builtin_amdgcn_mov_dpp(__float_as_int(v), 0x141, 0xF, 0xF, true));
  v += __int_as_float(__builtin_amdgcn_mov_dpp(__float_as_int(v), 0x140, 0xF, 0xF, true));
  return v;
}
__device__ __forceinline__ void retb_load(const Params& p, int tid, int bh, int n, RbRegs& R) {
  unsigned char* ws = p.ws; const int b = bh >> 3, h = bh & 7;
  const size_t go = ((size_t)b * SEQ + (size_t)n * 128 + (tid >> 3)) * 512 + h * 64 + (tid & 7) * 8;
  const bf16_t* RQ = (const bf16_t*)(ws + WS_RQ); const bf16_t* RK = (const bf16_t*)(ws + WS_RK); const bf16_t* RV = (const bf16_t*)(ws + WS_RV); const bf16_t* RG = (const bf16_t*)(ws + WS_RG);
  R.q0 = *(const u32x4*)(RQ + go); R.q1 = *(const u32x4*)(RQ + go + 64 * 512); R.k0 = *(const u32x4*)(RK + go); R.k1 = *(const u32x4*)(RK + go + 64 * 512);
  R.v0 = *(const u32x4*)(RV + go); R.v1 = *(const u32x4*)(RV + go + 64 * 512); R.g0 = *(const u32x4*)(RG + go); R.g1 = *(const u32x4*)(RG + go + 64 * 512);
  const int nr = n > 0 ? n : 1;
  R.r = *(const u32x4*)((const bf16_t*)(ws + WS_RP) + (size_t)(bh * 32 + nr) * 4096 + (tid >> 3) * 64 + (tid & 7) * 8);
}
__device__ __forceinline__ void retb_commit(LAS unsigned char* lds, int tid, const RbRegs& R) {
  const int lo = (tid >> 3) * RS + (tid & 7) * 16;
  *(LAS u32x4*)(lds + R_Q + lo) = R.q0; *(LAS u32x4*)(lds + R_Q + lo + 64 * RS) = R.q1; *(LAS u32x4*)(lds + R_K + lo) = R.k0; *(LAS u32x4*)(lds + R_K + lo + 64 * RS) = R.k1;
  *(LAS u32x4*)(lds + R_V + lo) = R.v0; *(LAS u32x4*)(lds + R_V + lo + 64 * RS) = R.v1; *(LAS u32x4*)(lds + R_RG + lo) = R.g0; *(LAS u32x4*)(lds + R_RG + lo + 64 * RS) = R.g1;
  *(LAS u32x4*)(lds + R_RT + lo) = R.r;
}
__device__ __forceinline__ void retb_compute(const Params& p, LAS unsigned char* lds, int tid, int bh, int n) {
  const int lane = tid & 63, wave = __builtin_amdgcn_readfirstlane(tid >> 6);
  const int l15 = lane & 15, g4 = lane >> 4, tq = l15 >> 2, tp = l15 & 3;
  unsigned char* ws = p.ws; const int b = bh >> 3, h = bh & 7;
  bf16_t* MIX = (bf16_t*)(ws + WS_H);
  const float l2g = ret_l2g(h);
  const int it = wave;
  const size_t tok0 = (size_t)b * SEQ + (size_t)n * 128;
  bf16x8 aq[2];
#pragma unroll
  for (int ks = 0; ks < 2; ++ks) aq[ks] = *(const LAS bf16x8*)(lds + R_Q + (16 * it + l15) * RS + (32 * ks + 8 * g4) * 2);
  const int jt_end = it | 1;
  for (int jt = 0; jt <= jt_end; ++jt) {
    f32x4 sv = {0.f, 0.f, 0.f, 0.f};
#pragma unroll
    for (int ks = 0; ks < 2; ++ks) { const bf16x8 bk = *(const LAS bf16x8*)(lds + R_K + (16 * jt + l15) * RS + (32 * ks + 8 * g4) * 2); sv = MFMA16(aq[ks], bk, sv); }
    const int jj = 16 * jt + l15;
#pragma unroll
    for (int r = 0; r < 4; ++r) { const int ii = 16 * it + 4 * g4 + r; const int df = ii - jj; const float v = (df >= 0) ? sv[r] * fexp2((float)df * l2g) : 0.f; *(LAS bf16_t*)(lds + R_P + ii * PRS + jj * 2) = f2bf(v); }
  }
  f32x4 oin[4], ocr[4];
#pragma unroll
  for (int et = 0; et < 4; ++et) { oin[et] = (f32x4){0.f, 0.f, 0.f, 0.f}; ocr[et] = (f32x4){0.f, 0.f, 0.f, 0.f}; }
  const int ks_end = it >> 1;
  for (int ks = 0; ks <= ks_end; ++ks) {
    const bf16x8 ap = *(const LAS bf16x8*)(lds + R_P + (16 * it + l15) * PRS + (32 * ks + 8 * g4) * 2);
#pragma unroll
    for (int et = 0; et < 4; ++et) { const LAS unsigned char* va = lds + R_V + (32 * ks + 8 * g4 + tq) * RS + (16 * et + 4 * tp) * 2; const bf16x8 bfr = cat8(tr16(va), tr16(va + 4 * RS)); oin[et] = MFMA16(ap, bfr, oin[et]); }
  }
  if (n > 0) {
#pragma unroll
    for (int ks = 0; ks < 2; ++ks)
#pragma unroll
      for (int et = 0; et < 4; ++et) { const LAS unsigned char* ra = lds + R_RT + (32 * ks + 8 * g4 + tq) * RS + (16 * et + 4 * tp) * 2; const bf16x8 br = cat8(tr16(ra), tr16(ra + 4 * RS)); ocr[et] = MFMA16(aq[ks], br, ocr[et]); }
  }
  {
    float o[4][4], sm[4], qv[4];
#pragma unroll
    for (int r = 0; r < 4; ++r) {
      const int ii = 16 * it + 4 * g4 + r; const float xi = fexp2((float)(ii + 1) * l2g);
      sm[r] = 0.f;
#pragma unroll
      for (int et = 0; et < 4; ++et) { o[r][et] = oin[et][r] + xi * ocr[et][r]; sm[r] += o[r][et]; }
    }
#pragma unroll
    for (int r = 0; r < 4; ++r) sm[r] = row16_sum(sm[r]);
#pragma unroll
    for (int r = 0; r < 4; ++r) { const float mu = sm[r] * (1.f / 64.f); qv[r] = 0.f;
#pragma unroll
      for (int et = 0; et < 4; ++et) { o[r][et] -= mu; qv[r] += o[r][et] * o[r][et]; } }
#pragma unroll
    for (int r = 0; r < 4; ++r) qv[r] = row16_sum(qv[r]);
#pragma unroll
    for (int r = 0; r < 4; ++r) {
      const int ii = 16 * it + 4 * g4 + r; const float rstd = __builtin_amdgcn_rsqf(qv[r] * (1.f / 64.f) + 1e-5f);
#pragma unroll
      for (int et = 0; et < 4; ++et) { const int e = 16 * et + l15; const float gv = bf2f(*(const LAS bf16_t*)(lds + R_RG + ii * RS + e * 2)); *(LAS bf16_t*)(lds + R_Q + ii * RS + e * 2) = f2bf(o[r][et] * rstd * siluf(gv)); }
    }
  }
#pragma unroll
  for (int i = 0; i < 2; ++i) { const int row = 16 * it + (lane >> 2), ch = (lane & 3) * 2 + i; const u32x4 w = *(const LAS u32x4*)(lds + R_Q + row * RS + ch * 16); *(u32x4*)(MIX + (tok0 + row) * DM + h * 64 + ch * 8) = w; }
}
#ifndef RETB_CPU
#define RETB_CPU 4
#endif
__device__ __forceinline__ void retb_unit(const Params& p, LAS unsigned char* lds, int bh, int nq) {
  int tid_ = threadIdx.x; asm volatile("" : "+v"(tid_));
  const int tid = tid_;
  constexpr int CPU = RETB_CPU;
  RbRegs R;
  retb_load(p, tid, bh, CPU * nq, R); retb_commit(lds, tid, R);
  __syncthreads();
#pragma unroll
  for (int c = 0; c < CPU; ++c) {
    if (c + 1 < CPU) retb_load(p, tid, bh, CPU * nq + c + 1, R);
    retb_compute(p, lds, tid, bh, CPU * nq + c);
    __syncthreads();
    if (c + 1 < CPU) { retb_commit(lds, tid, R); __syncthreads(); }
  }
}

__device__ __forceinline__ void phase6(const Params& p) {
  int tid_ = threadIdx.x; asm volatile("" : "+v"(tid_));
  const int tid = tid_, lane = tid & 63, wave = tid >> 6;
  const int gw = blockIdx.x * NWAVES + wave, NGW = gridDim.x * NWAVES;
  const float* mod = (const float*)(p.ws + WS_MOD);
  const bf16_t* Z = (const bf16_t*)(p.ws + WS_Z);
  constexpr int RPW = 16;
  for (int it = gw; it < MTOK / RPW; it += NGW) {
    const int row0 = it * RPW, b = row0 / SEQ;
    f32x4 gg[4];
    mod_read16(p, b, 2048, lane, gg);
#pragma unroll
    for (int j = 0; j < 4; ++j) { const int k = 4 * lane + 256 * j; gg[j] = *(const f32x4*)(p.g_post + k) * gg[j]; }
    for (int r = 0; r < RPW; r += 2) {
      const int row = row0 + r;
      const f32x4* xr = (const f32x4*)(p.x + (size_t)row * DM) + lane; const u32x2* zr = (const u32x2*)(Z + (size_t)row * DM) + lane;
      f32x4* orow = (f32x4*)(p.out + (size_t)row * DM) + lane;
      u32x2 zv[2][4]; f32x4 xv[2][4];
#pragma unroll
      for (int q = 0; q < 2; ++q)
#pragma unroll
        for (int j = 0; j < 4; ++j) { zv[q][j] = zr[q * (DM / 4) + 64 * j]; xv[q][j] = xr[q * (DM / 4) + 64 * j]; }
#pragma unroll
      for (int q = 0; q < 2; ++q) {
        f32x4 zf[4]; float ss = 0.f;
#pragma unroll
        for (int j = 0; j < 4; ++j) { zf[j] = (f32x4){bflo(zv[q][j].x), bfhi(zv[q][j].x), bflo(zv[q][j].y), bfhi(zv[q][j].y)}; ss += (zf[j].x * zf[j].x + zf[j].y * zf[j].y) + (zf[j].z * zf[j].z + zf[j].w * zf[j].w); }
        const float rstd = __builtin_amdgcn_rsqf(wave_sum(ss) * (1.f / DM) + 1e-6f);
#pragma unroll
        for (int j = 0; j < 4; ++j) orow[q * (DM / 4) + 64 * j] = xv[q][j] + gg[j] * (zf[j] * rstd);
      }
    }
  }
}

constexpr int AT_RS = 144, AT_TILE = 64 * AT_RS;
constexpr int AT_VRS = 192, AT_VTILE = 64 * AT_VRS;
constexpr int IMP_LD = 65;
constexpr int AT_K0 = 0, AT_V0 = 2 * AT_TILE, AT_IMP = 2 * AT_TILE + 2 * AT_VTILE, AT_IMPH = AT_IMP + 64 * IMP_LD * 4, AT_MASK = AT_IMPH + 4 * 64 * IMP_LD * 4, AT_INVL = AT_MASK + 64 * 8, AT_END = AT_INVL + 4 * 64 * 4;
static_assert(AT_MASK % 8 == 0 && AT_END <= 131072, "attention LDS map");
constexpr int QW_OFF = 131072 + 1024;
struct TileSrc { const bf16_t* K; const bf16_t* V; int ld; };
__device__ __forceinline__ int crow(int r, int hi) { return (r & 3) + 8 * (r >> 2) + 4 * hi; }
__device__ __forceinline__ void at_load(const TileSrc& S, int j, int tid, u32x4& kr, u32x4& vr) {
  const int row = tid >> 3, ch = tid & 7; const unsigned lo = (unsigned)(row * S.ld + ch * 8);
  const size_t tb = (size_t)(64 * j) * S.ld;
  kr = *(const u32x4*)(S.K + tb + lo); vr = *(const u32x4*)(S.V + tb + lo);
}
__device__ __forceinline__ void at_store(LAS unsigned char* lds, int buf, int tid, u32x4 kr, u32x4 vr) {
  const int row = tid >> 3, ch = tid & 7;
  *(LAS u32x4*)(lds + AT_K0 + buf * AT_TILE + row * AT_RS + ch * 16) = kr; *(LAS u32x4*)(lds + AT_V0 + buf * AT_VTILE + row * AT_VRS + ch * 16) = vr;
}
__device__ __forceinline__ float swapmax32(float v) { auto rr = __builtin_amdgcn_permlane32_swap(__float_as_uint(v), __float_as_uint(v), false, false); return fmaxf(__uint_as_float(rr[0]), __uint_as_float(rr[1])); }
__device__ __forceinline__ float swapsum32(float v) { auto rr = __builtin_amdgcn_permlane32_swap(__float_as_uint(v), __float_as_uint(v), false, false); return __uint_as_float(rr[0]) + __uint_as_float(rr[1]); }
struct AtLane { int r32, hi, c16, tq, tp; };
template <int MODE>
__device__ __forceinline__ void attn_tile2(LAS unsigned char* lds, int cur, int j, bool MASKED, const AtLane& L, const bf16x8 (&qr)[4],
                                           int klo, int khi, float cinit, float& l, f32x16& o0, f32x16& o1, int tokl, float& carry) {
  const int r32 = L.r32, hi = L.hi;
  const LAS unsigned char* Kt = lds + AT_K0 + cur * AT_TILE; const LAS unsigned char* Vt = lds + AT_V0 + cur * AT_VTILE;
  f32x16 p0, p1;
#pragma unroll
  for (int r = 0; r < 16; ++r) { p0[r] = cinit; p1[r] = cinit; }
#pragma unroll
  for (int d0 = 0; d0 < 4; ++d0) {
    const bf16x8 a0 = *(const LAS bf16x8*)(Kt + r32 * AT_RS + (16 * d0 + 8 * hi) * 2);
    p0 = MFMA32(a0, qr[d0], p0);
  }
#pragma unroll
  for (int d0 = 0; d0 < 4; ++d0) {
    const bf16x8 a1 = *(const LAS bf16x8*)(Kt + (32 + r32) * AT_RS + (16 * d0 + 8 * hi) * 2);
    p1 = MFMA32(a1, qr[d0], p1);
  }
  if (MASKED) {
    const int kb0 = 64 * j + 4 * hi;
#pragma unroll
    for (int r = 0; r < 16; ++r) {
      const int k0 = kb0 + (r & 3) + 8 * (r >> 2), k1 = k0 + 32;
      p0[r] = (k0 >= klo && k0 <= khi) ? p0[r] : -INFINITY;
      p1[r] = (k1 >= klo && k1 <= khi) ? p1[r] : -INFINITY;
    }
  }
  float rs = 0.f;
#pragma unroll
  for (int r = 0; r < 16; ++r) p0[r] = fexp2(p0[r]);
#pragma unroll
  for (int r = 0; r < 16; ++r) rs += p0[r];
#pragma unroll
  for (int r = 0; r < 16; ++r) p1[r] = fexp2(p1[r]);
#pragma unroll
  for (int r = 0; r < 16; ++r) rs += p1[r];
  l += rs;
  if (MODE == 4) {
    float X[2][4];
#pragma unroll
    for (int q4 = 0; q4 < 4; ++q4) {
      { auto rr = __builtin_amdgcn_permlane32_swap(__float_as_uint(p0[4 * q4 + 3]), __float_as_uint(p0[4 * q4 + 3]), false, false); X[0][q4] = __uint_as_float(hi ? rr[0] : rr[1]); }
      { auto rr = __builtin_amdgcn_permlane32_swap(__float_as_uint(p1[4 * q4 + 3]), __float_as_uint(p1[4 * q4 + 3]), false, false); X[1][q4] = __uint_as_float(hi ? rr[0] : rr[1]); }
    }
    LAS float* dst = (LAS float*)(lds + AT_IMPH) + (size_t)(tokl >> 8) * (64 * IMP_LD) + (tokl & 255) * IMP_LD + 16 * j + hi;
#pragma unroll
    for (int q4 = 0; q4 < 4; ++q4) {
      const float c0 = (p0[4 * q4] + p0[4 * q4 + 1]) + (p0[4 * q4 + 2] + p0[4 * q4 + 3]), c1 = (p1[4 * q4] + p1[4 * q4 + 1]) + (p1[4 * q4 + 2] + p1[4 * q4 + 3]);
      const float e0 = hi ? X[0][q4] : (q4 ? X[0][q4 ? q4 - 1 : 0] : carry);
      const float e1 = hi ? X[1][q4] : (q4 ? X[1][q4 ? q4 - 1 : 0] : X[0][3]);
      dst[2 * q4] = c0 + e0; dst[8 + 2 * q4] = c1 + e1;
    }
    carry = X[1][3];
  }
#pragma unroll
  for (int kb = 0; kb < 2; ++kb)
#pragma unroll
    for (int sx = 0; sx < 2; ++sx) {
      u32x4 pw;
      if (kb == 0) { pw.x = pk2(p0[8 * sx], p0[8 * sx + 1]); pw.y = pk2(p0[8 * sx + 2], p0[8 * sx + 3]); pw.z = pk2(p0[8 * sx + 4], p0[8 * sx + 5]); pw.w = pk2(p0[8 * sx + 6], p0[8 * sx + 7]); }
      else { pw.x = pk2(p1[8 * sx], p1[8 * sx + 1]); pw.y = pk2(p1[8 * sx + 2], p1[8 * sx + 3]); pw.z = pk2(p1[8 * sx + 4], p1[8 * sx + 5]); pw.w = pk2(p1[8 * sx + 6], p1[8 * sx + 7]); }
      const bf16x8 pf = __builtin_bit_cast(bf16x8, pw);
      const LAS unsigned char* va = Vt + (32 * kb + 16 * sx + 4 * hi + L.tq) * AT_VRS + (16 * L.c16 + 4 * L.tp) * 2;
      const bf16x8 v0 = cat8(tr16(va), tr16(va + 8 * AT_VRS));
      const bf16x8 v1 = cat8(tr16(va + 64), tr16(va + 64 + 8 * AT_VRS));
      o0 = MFMA32(v0, pf, o0); o1 = MFMA32(v1, pf, o1);
    }
}
template <int MODE>
__device__ __forceinline__ void attn_tile(LAS unsigned char* lds, int cur, int j, bool masked, const AtLane& L, const bf16x8 (&qr)[4],
                                          int klo, int khi, unsigned long long rowmask, float negb, float& l, f32x16& o0, f32x16& o1, int tokl, float& carry) {
  const bool en = (MODE == 1) ? (((rowmask >> j) & 1ull) != 0ull) : true;
  const float cinit = (MODE == 1 && !en) ? -INFINITY : negb;
  attn_tile2<MODE>(lds, cur, j, masked, L, qr, klo, khi, cinit, l, o0, o1, tokl, carry);
}
template <int MODE, bool PRE = false>
__device__ __forceinline__ void attn_run(LAS unsigned char* lds, const TileSrc& S, unsigned long long tiles, unsigned long long mtiles, const bf16x8 (&qr)[4],
                                         int klo, int khi, unsigned long long rowmask, float negb, float& l, f32x16& o0, f32x16& o1, int tokl,
                                         u32x4 preK = (u32x4){0u, 0u, 0u, 0u}, u32x4 preV = (u32x4){0u, 0u, 0u, 0u}) {
  int tid_ = threadIdx.x; asm volatile("" : "+v"(tid_));
  const int tid = tid_, lane = tid & 63;
  AtLane L; L.r32 = lane & 31; L.hi = lane >> 5; L.c16 = (lane >> 4) & 1; L.tq = (lane & 15) >> 2; L.tp = lane & 3;
  if (tiles == 0ull) return;
  unsigned long long rem = tiles;
  int j0 = __builtin_ctzll(rem); rem &= rem - 1;
  u32x4 kA, vA, kB, vB;
#define AT_NEXT(has, jn, jprev) const bool has = rem != 0ull; const int jn = has ? __builtin_ctzll(rem) : (jprev); rem &= (rem - 1ull) & (has ? ~0ull : 0ull)
  if (PRE) { kA = preK; vA = preV; } else at_load(S, j0, tid, kA, vA);
  AT_NEXT(h1_, j1_, j0);
  bool h1 = h1_; int j1 = j1_;
  at_load(S, j1, tid, kB, vB);
  at_store(lds, 0, tid, kA, vA);
  __syncthreads();
  float carry = 0.f;
  for (;;) {
    AT_NEXT(h2, j2, j1);
    at_load(S, j2, tid, kA, vA);
    attn_tile<MODE>(lds, 0, j0, ((mtiles >> j0) & 1ull) != 0ull, L, qr, klo, khi, rowmask, negb, l, o0, o1, tokl, carry);
    at_store(lds, 1, tid, kB, vB);
    __syncthreads();
    if (!h1) break;
    AT_NEXT(h3, j3, j2);
    at_load(S, j3, tid, kB, vB);
    attn_tile<MODE>(lds, 1, j1, ((mtiles >> j1) & 1ull) != 0ull, L, qr, klo, khi, rowmask, negb, l, o0, o1, tokl, carry);
    at_store(lds, 0, tid, kA, vA);
    __syncthreads();
    if (!h2) break;
    j0 = j2; j1 = j3; h1 = h3;
  }
#undef AT_NEXT
}

struct RowSet { bf16x8 q[4]; f32x16 o0, o1; float l, negb, carry, one; int klo, khi, tokl; unsigned long long rowmask; };
__device__ __forceinline__ void at_mask(f32x16& p0, f32x16& p1, int j, int hi, int klo, int khi) {
  const int kb0 = 64 * j + 4 * hi;
#pragma unroll
  for (int r = 0; r < 16; ++r) {
    const int k0 = kb0 + (r & 3) + 8 * (r >> 2), k1 = k0 + 32;
    p0[r] = (k0 >= klo && k0 <= khi) ? p0[r] : -INFINITY;
    p1[r] = (k1 >= klo && k1 <= khi) ? p1[r] : -INFINITY;
  }
}
template <bool FMA>
__device__ __forceinline__ void at_soft(f32x16& p0, f32x16& p1, float& l, float one) {
  float rs = 0.f;
#pragma unroll
  for (int r = 0; r < 16; ++r) p0[r] = fexp2(p0[r]);
#pragma unroll
  for (int r = 0; r < 16; ++r) rs = FMA ? __builtin_fmaf(p0[r], one, rs) : rs + p0[r];
#pragma unroll
  for (int r = 0; r < 16; ++r) p1[r] = fexp2(p1[r]);
#pragma unroll
  for (int r = 0; r < 16; ++r) rs = FMA ? __builtin_fmaf(p1[r], one, rs) : rs + p1[r];
  l += rs;
}
__device__ __forceinline__ void at_imp(LAS unsigned char* lds, const f32x16& p0, const f32x16& p1, int hi, int j, int tokl, float& carry) {
  float X[2][4];
#pragma unroll
  for (int q4 = 0; q4 < 4; ++q4) {
    { auto rr = __builtin_amdgcn_permlane32_swap(__float_as_uint(p0[4 * q4 + 3]), __float_as_uint(p0[4 * q4 + 3]), false, false); X[0][q4] = __uint_as_float(hi ? rr[0] : rr[1]); }
    { auto rr = __builtin_amdgcn_permlane32_swap(__float_as_uint(p1[4 * q4 + 3]), __float_as_uint(p1[4 * q4 + 3]), false, false); X[1][q4] = __uint_as_float(hi ? rr[0] : rr[1]); }
  }
  LAS float* dst = (LAS float*)(lds + AT_IMPH) + (size_t)(tokl >> 8) * (64 * IMP_LD) + (tokl & 255) * IMP_LD + 16 * j + hi;
#pragma unroll
  for (int q4 = 0; q4 < 4; ++q4) {
    const float c0 = (p0[4 * q4] + p0[4 * q4 + 1]) + (p0[4 * q4 + 2] + p0[4 * q4 + 3]), c1 = (p1[4 * q4] + p1[4 * q4 + 1]) + (p1[4 * q4 + 2] + p1[4 * q4 + 3]);
    const float e0 = hi ? X[0][q4] : (q4 ? X[0][q4 ? q4 - 1 : 0] : carry);
    const float e1 = hi ? X[1][q4] : (q4 ? X[1][q4 ? q4 - 1 : 0] : X[0][3]);
    dst[2 * q4] = c0 + e0; dst[8 + 2 * q4] = c1 + e1;
  }
  carry = X[1][3];
}
__device__ __forceinline__ void at_pv(const LAS unsigned char* Vt, const AtLane& L, const f32x16& p0, const f32x16& p1, f32x16& o0, f32x16& o1) {
#pragma unroll
  for (int kb = 0; kb < 2; ++kb)
#pragma unroll
    for (int sx = 0; sx < 2; ++sx) {
      u32x4 pw;
      if (kb == 0) { pw.x = pk2(p0[8 * sx], p0[8 * sx + 1]); pw.y = pk2(p0[8 * sx + 2], p0[8 * sx + 3]); pw.z = pk2(p0[8 * sx + 4], p0[8 * sx + 5]); pw.w = pk2(p0[8 * sx + 6], p0[8 * sx + 7]); }
      else { pw.x = pk2(p1[8 * sx], p1[8 * sx + 1]); pw.y = pk2(p1[8 * sx + 2], p1[8 * sx + 3]); pw.z = pk2(p1[8 * sx + 4], p1[8 * sx + 5]); pw.w = pk2(p1[8 * sx + 6], p1[8 * sx + 7]); }
      const bf16x8 pf = __builtin_bit_cast(bf16x8, pw);
      const LAS unsigned char* va = Vt + (32 * kb + 16 * sx + 4 * L.hi + L.tq) * AT_VRS + (16 * L.c16 + 4 * L.tp) * 2;
      const bf16x8 v0 = cat8(tr16(va), tr16(va + 8 * AT_VRS));
      const bf16x8 v1 = cat8(tr16(va + 64), tr16(va + 64 + 8 * AT_VRS));
      o0 = MFMA32(v0, pf, o0); o1 = MFMA32(v1, pf, o1);
    }
}
template <int MODE, int SETOFF, bool MSK>
__device__ __forceinline__ void attn_tile1(LAS unsigned char* lds, const LAS unsigned char* Kt, const LAS unsigned char* Vt, int j, const AtLane& L, RowSet& R, const LAS unsigned char* qlds) {
  constexpr bool masked = MSK;
  const int r32 = L.r32, hi = L.hi;
  const bool en = (MODE == 1) ? (((R.rowmask >> j) & 1ull) != 0ull) : true;
  const float ci = (MODE == 1 && !en) ? -INFINITY : R.negb;
  f32x16 p0, p1;
#pragma unroll
  for (int r = 0; r < 16; ++r) { p0[r] = ci; p1[r] = ci; }
#pragma unroll
  for (int d0 = 0; d0 < 4; ++d0) {
    const bf16x8 k0 = *(const LAS bf16x8*)(Kt + r32 * AT_RS + (16 * d0 + 8 * hi) * 2), k1 = *(const LAS bf16x8*)(Kt + (32 + r32) * AT_RS + (16 * d0 + 8 * hi) * 2);
    const bf16x8 qv = (SETOFF != 0 && MODE == 1) ? *(const LAS bf16x8*)(qlds + d0 * 4096) : R.q[d0];
    p0 = MFMA32(k0, qv, p0); p1 = MFMA32(k1, qv, p1);
  }
  if (masked) {
    if (MODE == 1) {
      const int kq = r32 + SETOFF - 4 * hi;
#pragma unroll
      for (int r = 0; r < 16; ++r) { const int kk = (r & 3) + 8 * (r >> 2); p0[r] = (kk <= kq) ? p0[r] : -INFINITY; p1[r] = (kk + 32 <= kq) ? p1[r] : -INFINITY; }
    } else at_mask(p0, p1, j, hi, R.klo, R.khi);
  }
  at_soft<SETOFF != 0>(p0, p1, R.l, R.one);
  if (MODE == 4) at_imp(lds, p0, p1, hi, j, R.tokl, R.carry);
  at_pv(Vt, L, p0, p1, R.o0, R.o1);
}
template <int MODE, bool MSK>
__device__ __forceinline__ void attn_tileW(LAS unsigned char* lds, int cur, int j, const AtLane& L, RowSet& A, RowSet& B) {
  const LAS unsigned char* Kt = lds + AT_K0 + cur * AT_TILE; const LAS unsigned char* Vt = lds + AT_V0 + cur * AT_VTILE;
  const LAS unsigned char* qlds = lds + AT_IMP + ((threadIdx.x >> 6) * 64 + (threadIdx.x & 63)) * 16;
  attn_tile1<MODE, 0, MSK>(lds, Kt, Vt, j, L, A, qlds);
  attn_tile1<MODE, 32, MSK>(lds, Kt, Vt, j, L, B, qlds);
}
struct TileRegs { u32x4 k0, k1, v0, v1; };
__device__ __forceinline__ void at_loadH(const TileSrc& S, int j, int ht, TileRegs& T) {
  const int row = ht >> 3, ch = ht & 7; const unsigned lo = (unsigned)(row * S.ld + ch * 8); const size_t tb = (size_t)(64 * j) * S.ld, hb = (size_t)32 * S.ld;
  T.k0 = *(const u32x4*)(S.K + tb + lo); T.k1 = *(const u32x4*)(S.K + tb + hb + lo); T.v0 = *(const u32x4*)(S.V + tb + lo); T.v1 = *(const u32x4*)(S.V + tb + hb + lo);
}
__device__ __forceinline__ void at_storeH(LAS unsigned char* lds, int buf, int ht, const TileRegs& T) {
  const int row = ht >> 3, ch = ht & 7;
  LAS unsigned char* kp = lds + AT_K0 + buf * AT_TILE + row * AT_RS + ch * 16; LAS unsigned char* vp = lds + AT_V0 + buf * AT_VTILE + row * AT_VRS + ch * 16;
  *(LAS u32x4*)kp = T.k0; *(LAS u32x4*)(kp + 32 * AT_RS) = T.k1; *(LAS u32x4*)vp = T.v0; *(LAS u32x4*)(vp + 32 * AT_VRS) = T.v1;
}
template <int MODE, bool PRE, bool ACT>
__device__ __forceinline__ void attn_runW(LAS unsigned char* lds, const TileSrc& S, unsigned long long tiles, unsigned long long mtiles, RowSet& RA, RowSet& RB, TileRegs& pre) {
  int tid_ = threadIdx.x; asm volatile("" : "+v"(tid_));
  const int tid = tid_, lane = tid & 63, ht = tid & 255;
  AtLane L; L.r32 = lane & 31; L.hi = lane >> 5; L.c16 = (lane >> 4) & 1; L.tq = (lane & 15) >> 2; L.tp = lane & 3;
  if (tiles == 0ull) return;
  unsigned long long rem = tiles;
  int j0 = __builtin_ctzll(rem); rem &= rem - 1;
  if (ACT) {
    __syncthreads();
    int cur = 0, j = j0;
    while (rem != 0ull) {
      attn_tileW<MODE, false>(lds, cur, j, L, RA, RB);
      __syncthreads();
      cur ^= 1; j = __builtin_ctzll(rem); rem &= rem - 1ull;
    }
    attn_tileW<MODE, true>(lds, cur, j, L, RA, RB);
    __syncthreads();
    return;
  }
  TileRegs TA, TB;
#define AT_NEXT(has, jn, jprev) const bool has = rem != 0ull; const int jn = has ? __builtin_ctzll(rem) : (jprev); rem &= (rem - 1ull) & (has ? ~0ull : 0ull)
  if (PRE) TA = pre; else at_loadH(S, j0, ht, TA);
  AT_NEXT(h1_, j1_, j0);
  bool h1 = h1_; int j1 = j1_;
  at_loadH(S, j1, ht, TB); at_storeH(lds, 0, ht, TA);
  __syncthreads();
  for (;;) {
    AT_NEXT(h2, j2, j1);
    at_loadH(S, j2, ht, TA); at_storeH(lds, 1, ht, TB);
    __syncthreads();
    if (!h1) break;
    AT_NEXT(h3, j3, j2);
    at_loadH(S, j3, ht, TB); at_storeH(lds, 0, ht, TA);
    __syncthreads();
    if (!h2) break;
    j0 = j2; j1 = j3; h1 = h3;
  }
#undef AT_NEXT
}

__device__ __forceinline__ float at_negb(const bf16x8 (&qr)[4], const unsigned* kb, bool two) {
  float qa = 0.f, qb = 0.f;
#pragma unroll
  for (int d0 = 0; d0 < 4; ++d0)
#pragma unroll
    for (int e = 0; e < 8; e += 2) { const float x = bf2f((unsigned short)qr[d0][e]), y = bf2f((unsigned short)qr[d0][e + 1]); qa += x * x; qb += y * y; }
  const float qn2 = swapsum32(qa + qb);
  const float k2 = __uint_as_float(kb[0]) + (two ? __uint_as_float(kb[1]) : 0.f);
  return -1.01f * __builtin_sqrtf(qn2 * k2);
}
__device__ __forceinline__ void win_unit(const Params& p, LAS unsigned char* lds, int b, int g, int bi) {
  int tid_ = threadIdx.x; asm volatile("" : "+v"(tid_));
  const int tid = tid_, lane = tid & 63, wave = __builtin_amdgcn_readfirstlane(tid >> 6), r32 = lane & 31, hi = lane >> 5;
  unsigned char* ws = p.ws;
  const int hh = wave >> 1, th = wave & 1, head = 4 * g + hh, tqp = 64 * bi + 32 * th + r32; const size_t token = (size_t)b * SEQ + tqp;
  const bf16_t* NQ = (const bf16_t*)(ws + WS_NQ);
  bf16x8 qr[4];
#pragma unroll
  for (int d0 = 0; d0 < 4; ++d0) qr[d0] = *(const bf16x8*)(NQ + token * 512 + head * 64 + 16 * d0 + 8 * hi);
  const float gw = sigmoidf(bf2f(((const bf16_t*)(ws + WS_NGL))[token * 32 + head * 3 + 2]));
  TileSrc S{(const bf16_t*)(ws + WS_KV6 + 4 * KV6_STRIDE) + (size_t)b * SEQ * 128 + 64 * g, (const bf16_t*)(ws + WS_KV6 + 5 * KV6_STRIDE) + (size_t)b * SEQ * 128 + 64 * g, 128};
  const int j0 = bi >= 8 ? bi - 8 : 0;
  const unsigned long long tiles = ((2ull << bi) - 1ull) & ~((1ull << j0) - 1ull);
  const unsigned long long mtiles = (1ull << bi) | (bi >= 8 ? (1ull << (bi - 8)) : 0ull);
  float l = 0.f; f32x16 o0, o1;
#pragma unroll
  for (int r = 0; r < 16; ++r) { o0[r] = 0.f; o1[r] = 0.f; }
  const float negb = at_negb(qr, (const unsigned*)(ws + WS_CTL) + CW_KB + (16 + b * 2 + g) * 2, true);
  attn_run<0>(lds, S, tiles, mtiles, qr, tqp - 511, tqp, 0ull, negb, l, o0, o1, 0);
  const float lt = swapsum32(l); const float sc = lt > 0.f ? gw / lt : 0.f;
  LAS unsigned char* stg = lds + wave * (32 * 144);
#pragma unroll
  for (int q4 = 0; q4 < 4; ++q4) {
    u32x2 w0, w1; w0.x = pk2(o0[4 * q4] * sc, o0[4 * q4 + 1] * sc); w0.y = pk2(o0[4 * q4 + 2] * sc, o0[4 * q4 + 3] * sc);
    w1.x = pk2(o1[4 * q4] * sc, o1[4 * q4 + 1] * sc); w1.y = pk2(o1[4 * q4 + 2] * sc, o1[4 * q4 + 3] * sc);
    *(LAS u32x2*)(stg + r32 * 144 + (8 * q4 + 4 * hi) * 2) = w0; *(LAS u32x2*)(stg + r32 * 144 + (32 + 8 * q4 + 4 * hi) * 2) = w1;
  }
  bf16_t* OWb = (bf16_t*)(ws + WS_OWIN) + ((size_t)b * SEQ + 64 * bi + 32 * th) * 512 + head * 64;
#pragma unroll
  for (int it = 0; it < 4; ++it) { const int row = 8 * it + (lane >> 3), ch = lane & 7; const u32x4 v = *(const LAS u32x4*)(stg + row * 144 + ch * 16); *(u32x4*)(OWb + (size_t)row * 512 + ch * 8) = v; }
  __syncthreads();
}

__device__ __forceinline__ void sort16_desc(unsigned (&a)[16]) {
#pragma unroll
  for (int ks = 1; ks <= 4; ++ks)
#pragma unroll
    for (int js = ks - 1; js >= 0; --js)
#pragma unroll
      for (int i = 0; i < 16; ++i) {
        const int k = 1 << ks, j = 1 << js, l = i ^ j;
        if (l > i) {
          const unsigned hi = a[i] > a[l] ? a[i] : a[l], lo = a[i] > a[l] ? a[l] : a[i];
          if ((i & k) == 0) { a[i] = hi; a[l] = lo; } else { a[i] = lo; a[l] = hi; }
        }
      }
}
#define RS_ZERO(R_) do { (R_).l = 0.f; (R_).carry = 0.f; _Pragma("unroll") for (int r_ = 0; r_ < 16; ++r_) { (R_).o0[r_] = 0.f; (R_).o1[r_] = 0.f; } } while (0)
#define RS_STAGE(AREA_, V0_, V1_) do { LAS unsigned char* stg_ = lds + (AREA_) * (32 * 144); _Pragma("unroll") for (int q4 = 0; q4 < 4; ++q4) { \
    u32x2 w0, w1; w0.x = pk2(V0_(4 * q4), V0_(4 * q4 + 1)); w0.y = pk2(V0_(4 * q4 + 2), V0_(4 * q4 + 3)); w1.x = pk2(V1_(4 * q4), V1_(4 * q4 + 1)); w1.y = pk2(V1_(4 * q4 + 2), V1_(4 * q4 + 3)); \
    *(LAS u32x2*)(stg_ + r32 * 144 + (8 * q4 + 4 * hi) * 2) = w0; *(LAS u32x2*)(stg_ + r32 * 144 + (32 + 8 * q4 + 4 * hi) * 2) = w1; } } while (0)
__device__ __forceinline__ void cs_unit(const Params& p, LAS unsigned char* lds, int b, int g, int bi, unsigned* nxt_ctr) {
  int tid_ = threadIdx.x; asm volatile("" : "+v"(tid_));
  const int tid = tid_, lane = tid & 63, wave = __builtin_amdgcn_readfirstlane(tid >> 6), r32 = lane & 31, hi = lane >> 5;
  unsigned char* ws = p.ws;
  const int hh = wave >> 1, th = wave & 1, head = 4 * g + hh, tokl = 32 * th + r32, tqp = 64 * bi + tokl; const size_t token = (size_t)b * SEQ + tqp;
  const bf16_t* NQ = (const bf16_t*)(ws + WS_NQ); const bf16_t* NGLp = (const bf16_t*)(ws + WS_NGL) + token * 32 + head * 3;
  bf16x8 qr[4];
#pragma unroll
  for (int d0 = 0; d0 < 4; ++d0) qr[d0] = *(const bf16x8*)(NQ + token * 512 + head * 64 + 16 * d0 + 8 * hi);
  const float gc = sigmoidf(bf2f(NGLp[0])), gs = sigmoidf(bf2f(NGLp[1]));
  TileSrc SS{(const bf16_t*)(ws + WS_KV6 + 2 * KV6_STRIDE) + (size_t)b * SEQ * 128 + 64 * g, (const bf16_t*)(ws + WS_KV6 + 3 * KV6_STRIDE) + (size_t)b * SEQ * 128 + 64 * g, 128};
  TileRegs pres; if (wave >= 4) at_loadH(SS, 0, tid & 255, pres);
  const int bg = b * 2 + g;
  TileSrc SC{(const bf16_t*)(ws + WS_KCMP) + (size_t)bg * 256 * 64, (const bf16_t*)(ws + WS_VCMP) + (size_t)bg * 256 * 64, 64};
  const int nmax = (64 * bi + 63 - 31) >> 4;
  const unsigned long long ctiles = (2ull << (nmax >> 6)) - 1ull;
  const int khi_c = (tqp - 31) >> 4;
  unsigned long long cmt = 0ull;
  for (int jj = 0; jj <= (nmax >> 6); ++jj) if (64 * jj + 63 > 4 * bi - 2) cmt |= 1ull << jj;
  float l = 0.f; f32x16 o0, o1;
#pragma unroll
  for (int r = 0; r < 16; ++r) { o0[r] = 0.f; o1[r] = 0.f; }
  const unsigned* kbw = (const unsigned*)(ws + WS_CTL) + CW_KB;
  attn_run<4>(lds, SC, ctiles, cmt, qr, 0, khi_c, 0ull, at_negb(qr, kbw + (32 + bg) * 2, false), l, o0, o1, tokl | (hh << 8));
  f32x16 t0, t1;
  { const float lt = swapsum32(l); const float il = lt > 0.f ? 1.f / lt : 0.f;
    if (hi == 0) ((LAS float*)(lds + AT_INVL))[hh * 64 + tokl] = il;
    const float gi = gc * il;
#pragma unroll
    for (int r = 0; r < 16; ++r) { t0[r] = gi * o0[r]; t1[r] = gi * o1[r]; } }
  const bool active = wave < 4; const int h2 = wave & 3, head2 = 4 * g + h2;
  bf16x8 qA2[4], qB2[4]; unsigned short gA2 = 0, gB2 = 0;
  if (active) { const size_t tokA = (size_t)b * SEQ + 64 * bi + r32, tokB = tokA + 32;
#pragma unroll
    for (int d0 = 0; d0 < 4; ++d0) { qA2[d0] = *(const bf16x8*)(NQ + tokA * 512 + head2 * 64 + 16 * d0 + 8 * hi); qB2[d0] = *(const bf16x8*)(NQ + tokB * 512 + head2 * 64 + 16 * d0 + 8 * hi); }
    gA2 = ((const bf16_t*)(ws + WS_NGL))[tokA * 32 + head2 * 3 + 1]; gB2 = ((const bf16_t*)(ws + WS_NGL))[tokB * 32 + head2 * 3 + 1]; }
  __syncthreads();
  {
    LAS unsigned long long* mk = (LAS unsigned long long*)(lds + AT_MASK);
    LAS float* imp = (LAS float*)(lds + AT_IMP);
    if (bi <= 15) { if (lane < 8) mk[8 * wave + lane] = (2ull << bi) - 1ull; }
    else {
      const LAS float* ih = (const LAS float*)(lds + AT_IMPH);
#pragma unroll
      for (int tt = 0; tt < 8; ++tt) { const int tk = 8 * wave + tt, o = tk * IMP_LD + lane; const LAS float* iv = (const LAS float*)(lds + AT_INVL) + tk;
        imp[o] = (ih[o] * iv[0] + ih[o + 64 * IMP_LD] * iv[64]) + (ih[o + 2 * 64 * IMP_LD] * iv[128] + ih[o + 3 * 64 * IMP_LD] * iv[192]); }
      __syncthreads();
      if (wave < 4) {
        const int tk0 = 16 * wave, q = lane & 3; const LAS float* irow = imp + (tk0 + (lane >> 2)) * IMP_LD + q;
        unsigned a[16];
#pragma unroll
        for (int i = 0; i < 16; ++i) { const int s = 4 * i + q; const unsigned kb = __float_as_uint(irow[4 * i]) + 1u; a[i] = (s >= 1 && s <= bi - 2) ? kb : 0u; }
        unsigned k0[16];
#pragma unroll
        for (int i = 0; i < 16; ++i) k0[i] = a[i];
        sort16_desc(a);
        unsigned m[16];
#pragma unroll
        for (int i = 0; i < 16; ++i) { const unsigned y = (unsigned)__builtin_amdgcn_mov_dpp((int)a[15 - i], 0xB1, 0xF, 0xF, true); m[i] = a[i] > y ? a[i] : y; }
#pragma unroll
        for (int js = 3; js >= 0; --js)
#pragma unroll
          for (int i = 0; i < 16; ++i) { const int l = i ^ (1 << js); if (l > i) { const unsigned hi_ = m[i] > m[l] ? m[i] : m[l], lo_ = m[i] > m[l] ? m[l] : m[i]; m[i] = hi_; m[l] = lo_; } }
        unsigned t = 0xffffffffu;
#pragma unroll
        for (int i = 0; i < 13; ++i) { const unsigned y = (unsigned)__builtin_amdgcn_mov_dpp((int)m[12 - i], 0x4E, 0xF, 0xF, true); const unsigned mx = m[i] > y ? m[i] : y; t = mx < t ? mx : t; }
        unsigned cm = 0u;
#pragma unroll
        for (int i = 0; i < 16; ++i) cm |= (k0[i] >= t ? 1u : 0u) << i;
        unsigned long long x = cm;
        x = (x | (x << 24)) & 0x000000FF000000FFull; x = (x | (x << 12)) & 0x000F000F000F000Full;
        x = (x | (x << 6)) & 0x0303030303030303ull; x = (x | (x << 3)) & 0x1111111111111111ull;
        x <<= q;
        unsigned xl = (unsigned)x, xh = (unsigned)(x >> 32);
        xl |= (unsigned)__builtin_amdgcn_mov_dpp((int)xl, 0xB1, 0xF, 0xF, true); xh |= (unsigned)__builtin_amdgcn_mov_dpp((int)xh, 0xB1, 0xF, 0xF, true);
        xl |= (unsigned)__builtin_amdgcn_mov_dpp((int)xl, 0x4E, 0xF, 0xF, true); xh |= (unsigned)__builtin_amdgcn_mov_dpp((int)xh, 0x4E, 0xF, 0xF, true);
        const bool tie = (__builtin_popcount(xl) + __builtin_popcount(xh)) != 13;
        const unsigned long long forced = 1ull | (1ull << bi) | (1ull << (bi - 1));
        if (q == 0) mk[tk0 + (lane >> 2)] = (((unsigned long long)xh << 32) | xl) | forced;
        unsigned long long todo = __ballot(tie && q == 0);
        while (todo != 0ull) {
          const int ln = __builtin_ctzll(todo); todo &= todo - 1ull;
          const int tok = tk0 + (ln >> 2);
          const unsigned T = (unsigned)__builtin_amdgcn_readlane((int)t, ln);
          const bool cand = lane >= 1 && lane <= bi - 2;
          const unsigned key = cand ? (__float_as_uint(imp[tok * IMP_LD + lane]) + 1u) : 0u;
          const unsigned long long gt = __ballot(key > T), eq = __ballot(key == T);
          const int need = 13 - (int)__builtin_popcountll(gt);
          const int below = (int)__builtin_amdgcn_mbcnt_hi((unsigned)(eq >> 32), __builtin_amdgcn_mbcnt_lo((unsigned)eq, 0u));
          const bool sel = (key > T) || (key == T && below < need);
          const unsigned long long msk = __ballot(sel) | forced;
          if (lane == 0) mk[tok] = msk;
        }
      }
    }
    __syncthreads();
  }
  unsigned long long uni = ((const LAS unsigned long long*)(lds + AT_MASK))[lane];
  { unsigned ulo = (unsigned)uni, uhi = (unsigned)(uni >> 32);
#define DPP_OR(V, CTRL, RM) V |= (unsigned)__builtin_amdgcn_update_dpp(0, (int)V, CTRL, RM, 0xF, false)
    DPP_OR(ulo, 0xB1, 0xF); DPP_OR(uhi, 0xB1, 0xF); DPP_OR(ulo, 0x4E, 0xF); DPP_OR(uhi, 0x4E, 0xF); DPP_OR(ulo, 0x141, 0xF); DPP_OR(uhi, 0x141, 0xF);
    DPP_OR(ulo, 0x140, 0xF); DPP_OR(uhi, 0x140, 0xF); DPP_OR(ulo, 0x142, 0xA); DPP_OR(uhi, 0x142, 0xA); DPP_OR(ulo, 0x143, 0xC); DPP_OR(uhi, 0x143, 0xC);
#undef DPP_OR
    uni = ((unsigned long long)(unsigned)__builtin_amdgcn_readlane((int)uhi, 63) << 32) | (unsigned)__builtin_amdgcn_readlane((int)ulo, 63); }
  __syncthreads();
  { LAS f32x4* pk = (LAS f32x4*)(lds + AT_IMPH) + wave * 64 + lane;
#pragma unroll
    for (int k = 0; k < 4; ++k) { pk[k * 512] = (f32x4){t0[4 * k], t0[4 * k + 1], t0[4 * k + 2], t0[4 * k + 3]}; pk[(4 + k) * 512] = (f32x4){t1[4 * k], t1[4 * k + 1], t1[4 * k + 2], t1[4 * k + 3]}; } }
  __syncthreads();
  const unsigned long long stiles = uni & ((2ull << bi) - 1ull), smt = 1ull << bi;
  if (active) {
    RowSet A, B;
    const int tqA = 64 * bi + r32, tqB = tqA + 32;
#pragma unroll
    for (int d0 = 0; d0 < 4; ++d0) { A.q[d0] = qA2[d0]; B.q[d0] = qB2[d0]; }
    { const float gsA_ = sigmoidf(bf2f(gA2)), gsB_ = sigmoidf(bf2f(gB2));
      LAS float* gp = (LAS float*)(lds + AT_INVL) + wave * 64 + lane;
      if (hi == 0) { gp[0] = gsA_; gp[32] = gsB_; } }
    A.rowmask = ((const LAS unsigned long long*)(lds + AT_MASK))[r32]; B.rowmask = ((const LAS unsigned long long*)(lds + AT_MASK))[32 + r32];
    RS_ZERO(A); RS_ZERO(B);
    { float one_ = 1.0f; asm volatile("" : "+v"(one_)); A.one = one_; B.one = one_; }
    A.klo = 0; B.klo = 0; A.khi = tqA; B.khi = tqB; A.tokl = 0; B.tokl = 0;
    A.negb = at_negb(A.q, kbw + bg * 2, true); B.negb = at_negb(B.q, kbw + bg * 2, true);
    { LAS unsigned char* qw = lds + AT_IMP + (wave * 64 + lane) * 16;
#pragma unroll
      for (int d0 = 0; d0 < 4; ++d0) *(LAS bf16x8*)(qw + d0 * 4096) = B.q[d0]; }
    attn_runW<1, true, true>(lds, SS, stiles, smt, A, B, pres);
    int nxq = 0; if (threadIdx.x == 0) nxq = (int)atomicAdd(nxt_ctr, 1u);
    int t2_ = threadIdx.x; asm volatile("" : "+v"(t2_));
    const int lane = t2_ & 63, wave = __builtin_amdgcn_readfirstlane(t2_ >> 6), r32 = lane & 31, hi = lane >> 5;
    const float gsA = ((const LAS float*)(lds + AT_INVL))[wave * 64 + r32], gsB = ((const LAS float*)(lds + AT_INVL))[wave * 64 + 32 + r32];
    const LAS f32x4* pk = (const LAS f32x4*)(lds + AT_IMPH) + (wave * 2) * 64 + lane;
    { f32x16 u0, u1;
#pragma unroll
      for (int k = 0; k < 4; ++k) { const f32x4 a = pk[k * 512], c = pk[(4 + k) * 512]; u0[4 * k] = a[0]; u0[4 * k + 1] = a[1]; u0[4 * k + 2] = a[2]; u0[4 * k + 3] = a[3]; u1[4 * k] = c[0]; u1[4 * k + 1] = c[1]; u1[4 * k + 2] = c[2]; u1[4 * k + 3] = c[3]; }
      const float lt = swapsum32(A.l); const float sc = lt > 0.f ? gsA / lt : 0.f;
#define WV0(i) (u0[i] + sc * A.o0[i])
#define WV1(i) (u1[i] + sc * A.o1[i])
      RS_STAGE(wave * 2, WV0, WV1);
#undef WV0
#undef WV1
    }
    { f32x16 u0, u1;
#pragma unroll
      for (int k = 0; k < 4; ++k) { const f32x4 a = pk[k * 512 + 64], c = pk[(4 + k) * 512 + 64]; u0[4 * k] = a[0]; u0[4 * k + 1] = a[1]; u0[4 * k + 2] = a[2]; u0[4 * k + 3] = a[3]; u1[4 * k] = c[0]; u1[4 * k + 1] = c[1]; u1[4 * k + 2] = c[2]; u1[4 * k + 3] = c[3]; }
      const float lt = swapsum32(B.l); const float sc = lt > 0.f ? gsB / lt : 0.f;
#define WV0(i) (u0[i] + sc * B.o0[i])
#define WV1(i) (u1[i] + sc * B.o1[i])
      RS_STAGE(wave * 2 + 1, WV0, WV1);
#undef WV0
#undef WV1
    }
    if (threadIdx.x == 0) *(LAS int*)(lds + QW_OFF) = nxq;
    __syncthreads();
  } else {
    u32x4 owv[8], ngv[8];
    { const size_t trow = (size_t)b * SEQ + 64 * bi; const bf16_t* OW = (const bf16_t*)(ws + WS_OWIN) + trow * 512 + head2 * 64; const bf16_t* NGp = (const bf16_t*)(ws + WS_NG) + trow * 512 + head2 * 64;
#pragma unroll
      for (int it = 0; it < 8; ++it) { const int row = 8 * it + (lane >> 3), ch = lane & 7; owv[it] = *(const u32x4*)(OW + (size_t)row * 512 + ch * 8); ngv[it] = *(const u32x4*)(NGp + (size_t)row * 512 + ch * 8); } }
    RowSet A, B;
    attn_runW<1, true, false>(lds, SS, stiles, smt, A, B, pres);
    __syncthreads();
    bf16_t* MXb = (bf16_t*)(ws + WS_H) + ((size_t)b * SEQ + 64 * bi) * DM + 512 + head2 * 64;
#pragma unroll
    for (int it = 0; it < 8; ++it) {
      const int row = 8 * it + (lane >> 3), ch = lane & 7;
      const u32x4 a = *(const LAS u32x4*)(lds + (h2 * 2 + (row >> 5)) * (32 * 144) + (row & 31) * 144 + ch * 16); const u32x4 ow = owv[it], ng = ngv[it];
      u32x4 w;
      w.x = pk2((bflo(a.x) + bflo(ow.x)) * siluf(bflo(ng.x)), (bfhi(a.x) + bfhi(ow.x)) * siluf(bfhi(ng.x)));
      w.y = pk2((bflo(a.y) + bflo(ow.y)) * siluf(bflo(ng.y)), (bfhi(a.y) + bfhi(ow.y)) * siluf(bfhi(ng.y)));
      w.z = pk2((bflo(a.z) + bflo(ow.z)) * siluf(bflo(ng.z)), (bfhi(a.z) + bfhi(ow.z)) * siluf(bfhi(ng.z)));
      w.w = pk2((bflo(a.w) + bflo(ow.w)) * siluf(bflo(ng.w)), (bfhi(a.w) + bfhi(ow.w)) * siluf(bfhi(ng.w)));
      *(u32x4*)(MXb + (size_t)row * DM + ch * 8) = w;
    }
  }
  __syncthreads();
}

__device__ __forceinline__ void compress_unit(const Params& p, LAS unsigned char* lds, int cu, int half) {
  unsigned char* ws = p.ws;
  const int kv = cu >> 4, bg = cu & 15, b = bg >> 1, g = bg & 1;
  bf16_t* HID = (bf16_t*)(ws + WS_HID) + ((size_t)kv * 4096 + bg * 256) * 256;
  float* PART = (float*)(ws + WS_PART) + (size_t)cu * 65536;
  unsigned* flag = (unsigned*)(ws + WS_CTL) + CW_CMPF + 16 * cu;
  {
    pg8::Gemm gm{(const bf16_t*)(ws + WS_KV6 + (size_t)kv * KV6_STRIDE) + ((size_t)b * SEQ) * 128 + 64 * g, (const bf16_t*)(ws + (kv ? WS_W1V_T : WS_W1K_T)), 256, 256, 2048, 2048, 256, 2048};
    pg8::OneUnit S{1};
    EpiHidSolo E{HID, (const float*)(ws + WS_BIAS1) + kv * 256, PART, flag};
    pg8::gemm_phase<EpiHidSolo, pg8::OneUnit>(lds, gm, S, E);
  }
  asm volatile("s_waitcnt vmcnt(0)" ::: "memory"); __builtin_amdgcn_fence(__ATOMIC_RELEASE, "workgroup"); __syncthreads(); __builtin_amdgcn_fence(__ATOMIC_ACQUIRE, "workgroup");
  int tid_ = threadIdx.x; asm volatile("" : "+v"(tid_));
  const int tid = tid_, lane = tid & 63, wave = __builtin_amdgcn_readfirstlane(tid >> 6), l15 = lane & 15, g4 = lane >> 4;
  const bf16_t* W2 = (const bf16_t*)(ws + (kv ? WS_W2V_T : WS_W2K_T));
  f32x4 acc[2][4];
#pragma unroll
  for (int t = 0; t < 2; ++t)
#pragma unroll
    for (int ct = 0; ct < 4; ++ct) acc[t][ct] = (f32x4){0.f, 0.f, 0.f, 0.f};
  for (int ks = 0; ks < 8; ++ks) {
    bf16x8 a[2];
#pragma unroll
    for (int t = 0; t < 2; ++t) a[t] = *(const bf16x8*)(HID + (size_t)(16 * (2 * wave + t) + l15) * 256 + 32 * ks + 8 * g4);
#pragma unroll
    for (int ct = 0; ct < 4; ++ct) { const bf16x8 bw = *(const bf16x8*)(W2 + (size_t)(16 * ct + l15) * 256 + 32 * ks + 8 * g4);
#pragma unroll
      for (int t = 0; t < 2; ++t) acc[t][ct] = MFMA16(a[t], bw, acc[t][ct]); }
  }
  bf16_t* OUT = (bf16_t*)(ws + (kv ? WS_VCMP : WS_KCMP)) + (size_t)bg * 256 * 64;
  const float* cosn = (const float*)(ws + WS_COSN); const float* sinn = (const float*)(ws + WS_SINN);
  float kmx = 0.f;
#pragma unroll
  for (int t = 0; t < 2; ++t)
#pragma unroll
    for (int r = 0; r < 4; ++r) {
      const int n = 16 * (2 * wave + t) + 4 * g4 + r; const int nc = n < 255 ? n : 254;
      const size_t tp = (size_t)b * SEQ + 16 * nc + 31;
      float ss = 0.f;
#pragma unroll
      for (int ct = 0; ct < 4; ++ct) {
        float x = acc[t][ct][r]; int e = 16 * ct + l15;
        if (ct == 0) {
          const float pr = __shfl_xor(x, 8);
          if (kv == 0) { const int f = l15 & 7; const float cs = cosn[tp * 8 + f], sn = sinn[tp * 8 + f];
            x = (l15 < 8) ? x * cs - pr * sn : pr * sn + x * cs;
            e = (l15 < 4) ? l15 : (l15 < 8) ? l15 + 4 : (l15 < 12) ? l15 - 4 : l15; }
        }
        OUT[(size_t)n * 64 + e] = (n < 255) ? f2bf(x) : (bf16_t)0;
        ss += x * x;
      }
      if (kv == 0) {
#pragma unroll
        for (int o = 1; o < 16; o <<= 1) ss += __shfl_xor(ss, o);
        kmx = fmaxf(kmx, (n < 255) ? ss : 0.f);
      }
    }
  if (kv == 0) {
    kmx = fmaxf(kmx, __shfl_xor(kmx, 16)); kmx = fmaxf(kmx, __shfl_xor(kmx, 32));
    if (lane == 0) atomicMax((unsigned*)(ws + WS_CTL) + CW_KB + (2 * 16 + bg) * 2, __float_as_uint(kmx));
  }
}

#define XB_TMO      128
#define XB_XCNT(j)  (256  + 64 * (j))
#define XB_XSUB(j)  (1280 + 64 * (j))
#define XB_XGEN(j)  (2304 + 64 * (j))
#define XB_TOP      3328
#define XB_TOPGEN   3392
#define XCD_BAR_WORDS 3456
#define XB_SPIN_CAP (1u << 20)
constexpr int CW_BAR = 4096;
constexpr int XBST_OFF = 131072 + 2048;
__device__ __forceinline__ unsigned xb_ld(unsigned* p)              { return __hip_atomic_load(p, __ATOMIC_RELAXED, __HIP_MEMORY_SCOPE_AGENT); }
__device__ __forceinline__ unsigned xb_add(unsigned* p, unsigned v) { return __hip_atomic_fetch_add(p, v, __ATOMIC_RELAXED, __HIP_MEMORY_SCOPE_AGENT); }
__device__ __forceinline__ unsigned xb_xcc_id() { return (unsigned)__builtin_amdgcn_s_getreg((3 << 11) | 20) & 0xFu; }
#define XB_SPIN(cond, bar) do { unsigned _sp = 0; while (cond) { __builtin_amdgcn_s_sleep(1); \
    if ((++_sp & 255u) == 0u) { if (xb_ld(&(bar)[XB_TMO])) break; if (_sp > XB_SPIN_CAP) { atomicAdd(&(bar)[XB_TMO], 1u); break; } } } } while (0)
struct XcdBarrier { unsigned* bar; unsigned x; volatile LAS unsigned* st; };
__device__ __forceinline__ XcdBarrier xcd_barrier_post(unsigned* bar, volatile LAS unsigned* st) {
  XcdBarrier b; b.bar = bar; b.x = xb_xcc_id(); b.st = st;
  if (threadIdx.x == 0) (void)xb_add(&bar[XB_XCNT(b.x)], 1u);
  return b;
}
__device__ __forceinline__ void xcd_barrier_complete(unsigned* bar, unsigned x, unsigned& nloc, unsigned& nx) {
  const unsigned G = gridDim.x * gridDim.y * gridDim.z;
  unsigned sum, cnt, mine, sp = 0u;
  for (;;) {
    sum = 0u; cnt = 0u; mine = 0u;
#pragma unroll
    for (unsigned j = 0; j < 16; ++j) { const unsigned c = xb_ld(&bar[XB_XCNT(j)]); sum += c; cnt += (c > 0u) ? 1u : 0u; mine = (j == x) ? c : mine; }
    if (sum == G) break;
    __builtin_amdgcn_s_sleep(1);
    if ((++sp & 255u) == 0u) { if (xb_ld(&bar[XB_TMO])) break; if (sp > XB_SPIN_CAP) { atomicAdd(&bar[XB_TMO], 1u); break; } }
  }
  nloc = mine > 0u ? mine : 1u; nx = cnt > 0u ? cnt : 1u;
}
__device__ __forceinline__ void xcd_barrier(const XcdBarrier& b) {
  asm volatile("s_waitcnt vmcnt(0)" ::: "memory");
  __syncthreads();
  if (threadIdx.x == 0) {
    unsigned* bar = b.bar;
    __builtin_amdgcn_s_waitcnt(0);
    unsigned nloc = b.st[0], nx = b.st[1];
    if (nloc == 0u) { xcd_barrier_complete(bar, b.x, nloc, nx); b.st[0] = nloc; b.st[1] = nx; }
    const unsigned old = xb_add(&bar[XB_XSUB(b.x)], 1u);
    const unsigned gen = old / nloc;
    if (old + 1u == (gen + 1u) * nloc) {
      __builtin_amdgcn_fence(__ATOMIC_RELEASE, "agent");
      asm volatile("s_waitcnt vmcnt(0)" ::: "memory");
      const unsigned og = xb_add(&bar[XB_TOP], 1u);
      const unsigned tg = og / nx;
      if (og + 1u == (tg + 1u) * nx) xb_add(&bar[XB_TOPGEN], 1u);
      else XB_SPIN(xb_ld(&bar[XB_TOPGEN]) == tg, bar);
      __builtin_amdgcn_fence(__ATOMIC_ACQUIRE, "agent");
      xb_add(&bar[XB_XGEN(b.x)], 1u);
      asm volatile("s_waitcnt vmcnt(0)" ::: "memory");
    } else {
      XB_SPIN(xb_ld(&bar[XB_XGEN(b.x)]) == gen, bar);
      __builtin_amdgcn_fence(__ATOMIC_ACQUIRE, "agent");
      asm volatile("s_waitcnt vmcnt(0)" ::: "memory");
    }
  }
  __syncthreads();
}

__global__ void __launch_bounds__(NTHREADS, 2) fwd_megakernel(Params p) {
  extern __shared__ __attribute__((aligned(16))) unsigned char lds_raw[];
  LAS unsigned char* lds = (LAS unsigned char*)lds_raw;
  const int lo = p.ph_lo, hi = p.ph_hi;
  unsigned char* ws = p.ws;
  if (threadIdx.x < 2) ((LAS unsigned*)(lds + XBST_OFF))[threadIdx.x] = 0u;
  __syncthreads();
  XcdBarrier bar = xcd_barrier_post((unsigned*)(ws + WS_CTL) + CW_BAR, (volatile LAS unsigned*)(lds + XBST_OFF));
#define IN(k) (lo <= (k) && (k) < hi)
#define SEAM(k) do { if (IN(k) && IN((k) + 1)) xcd_barrier(bar); } while (0)
  if (IN(0)) phase0(p, lds);
  SEAM(0);
  if (IN(1)) { phase1(p); phase0b(p, lds); }
  SEAM(1);
  if (IN(2)) {
    pg8::Gemm g{(const bf16_t*)(ws + WS_H), (const bf16_t*)(ws + WS_WIN_T), MTOK, NPROJ, DM, DM, 128, DM};
    pg8::StaticOrder S; S.init(MTOK, NPROJ, gridDim.x, blockIdx.x, WGM_P2);
    EpiProj E{ws};
    pg8::gemm_phase<EpiProj, pg8::StaticOrder>(lds, g, S, E);
  }
  SEAM(2);
#define QFETCH(dst, ctrp) do { __syncthreads(); if (threadIdx.x == 0) *(LAS int*)(lds + QW_OFF) = (int)atomicAdd((ctrp), 1u); __syncthreads(); dst = *(LAS int*)(lds + QW_OFF); } while (0)
#define QSCAN(dstq, ctr0_, NQ_) do { __syncthreads(); \
    if (threadIdx.x < 8) ((LAS int*)(lds + QW_OFF))[4 + threadIdx.x] = (int)xb_ld((ctr0_) + 16 * threadIdx.x); \
    __syncthreads(); \
    int best_ = -1, bv_ = (NQ_); \
    _Pragma("unroll") for (int k_ = 0; k_ < 8; ++k_) { const int v_ = ((LAS int*)(lds + QW_OFF))[4 + k_]; if (v_ < bv_) { bv_ = v_; best_ = k_; } } \
    dstq = best_; } while (0)
  if (IN(3)) {
    unsigned* ctr0 = (unsigned*)(ws + WS_CTL) + CW_Q3;
    constexpr int NQ3 = 4 + 8 + 128;
    int qx = (int)(bar.x & 7u), u;
    QFETCH(u, ctr0 + 16 * qx);
    for (;;) {
      while (u >= NQ3) { int q2; QSCAN(q2, ctr0, NQ3); if (q2 < 0) break; qx = q2; QFETCH(u, ctr0 + 16 * qx); }
      if (u >= NQ3) break;
      int nx = 0; if (u >= 12 && threadIdx.x == 0) nx = (int)atomicAdd(ctr0 + 16 * qx, 1u);
      if (u < 4) compress_unit(p, lds, ((u & 3) >> 1) * 16 + 2 * qx + (u & 1), 0);
      else if (u < 12) reta_unit(p, lds, 8 * qx + (u - 4));
      else { const int w = u - 12; win_unit(p, lds, qx, w & 1, 63 - (w >> 1)); }
      if (u < 12 && threadIdx.x == 0) nx = (int)atomicAdd(ctr0 + 16 * qx, 1u);
      if (threadIdx.x == 0) *(LAS int*)(lds + QW_OFF) = nx;
      __syncthreads();
      u = *(LAS int*)(lds + QW_OFF);
    }
  }
  SEAM(3);
  if (IN(4)) {
    unsigned* ctr0 = (unsigned*)(ws + WS_CTL) + CW_Q4;
    constexpr int NRB = 8 * (32 / RETB_CPU);
    constexpr int NQ4 = 128 + NRB;
    int qx = (int)(bar.x & 7u), u;
    QFETCH(u, ctr0 + 16 * qx);
    for (;;) {
      while (u >= NQ4) { int q2; QSCAN(q2, ctr0, NQ4); if (q2 < 0) break; qx = q2; QFETCH(u, ctr0 + 16 * qx); }
      if (u >= NQ4) break;
      if (u >= 112 && u < 112 + NRB) { const int r = u - 112;
        int nx = 0; if (threadIdx.x == 0) nx = (int)atomicAdd(ctr0 + 16 * qx, 1u);
        retb_unit(p, lds, 8 * qx + r / (32 / RETB_CPU), r % (32 / RETB_CPU));
        if (threadIdx.x == 0) *(LAS int*)(lds + QW_OFF) = nx; }
      else { const int c = (u < 112) ? u : u - NRB; cs_unit(p, lds, qx, c & 1, 63 - (c >> 1), ctr0 + 16 * qx); }
      __syncthreads();
      u = *(LAS int*)(lds + QW_OFF);
    }
  }
  SEAM(4);
  const bool fused_out = (gridDim.x == 256);
  if (IN(5)) {
    pg8::Gemm g{(const bf16_t*)(ws + WS_H), (const bf16_t*)(ws + WS_WOUT_T), MTOK, DM, DM, DM, 128, DM};
    pg8::StaticOrder S; S.init(MTOK, DM, gridDim.x, blockIdx.x, WGM_P5);
    if (fused_out) {
      EpiOut E{p.x, p.out, (const float*)(ws + WS_GG), (float*)(ws + WS_ROWSS), (unsigned*)(ws + WS_CTL) + CW_PANEL, lds};
      pg8::gemm_phase<EpiOut, pg8::StaticOrder>(lds, g, S, E);
    } else {
      EpiZ E{(bf16_t*)(ws + WS_Z), (float*)(ws + WS_ROWSS)};
      pg8::gemm_phase<EpiZ, pg8::StaticOrder>(lds, g, S, E);
    }
  }
  if (!fused_out) {
    SEAM(5);
    if (IN(6)) phase6(p);
  }
#undef IN
#undef SEAM
}

extern "C" void kernel_launch(void* const* d_in, const int* in_sizes, int n_in,
                              void* d_out, int out_size, void* d_ws, size_t ws_size,
                              hipStream_t stream) {
  static int grid_blocks = 0;
  if (!grid_blocks) {
    if (n_in != 15 || out_size != MTOK * DM || ws_size < WS_END) { fprintf(stderr, "kernel_launch: unexpected shapes (n_in %d out %d ws %zu)\n", n_in, out_size, ws_size); grid_blocks = -1; return; }
    int dev = 0, cus = 0, per_cu = 0;
    hipGetDevice(&dev);
    hipDeviceGetAttribute(&cus, hipDeviceAttributeMultiprocessorCount, dev);
    hipFuncSetAttribute((const void*)fwd_megakernel, hipFuncAttributeMaxDynamicSharedMemorySize, LDS_BYTES);
    hipOccupancyMaxActiveBlocksPerMultiprocessor(&per_cu, (const void*)fwd_megakernel, NTHREADS, LDS_BYTES);
    if (per_cu < 1) per_cu = 1;
    grid_blocks = cus * 1;
    fprintf(stderr, "grid %d (cus %d per_cu %d)\n", grid_blocks, cus, per_cu);
  }
  if (grid_blocks < 0) return;
  hipMemsetAsync((char*)d_ws + WS_CTL, 0, CTL_USED, stream);
  Params p{};
  p.x = (const float*)d_in[0]; p.c = (const float*)d_in[1]; p.pos = (const int*)d_in[2]; p.w_ada = (const float*)d_in[3]; p.b_ada = (const float*)d_in[4];
  p.g_pre = (const float*)d_in[5]; p.g_post = (const float*)d_in[6]; p.w_in = (const float*)d_in[7]; p.w_out = (const float*)d_in[8];
  p.pe_k = (const float*)d_in[9]; p.w1_k = (const float*)d_in[10]; p.w2_k = (const float*)d_in[11]; p.pe_v = (const float*)d_in[12]; p.w1_v = (const float*)d_in[13]; p.w2_v = (const float*)d_in[14];
  p.out = (float*)d_out; p.ws = (unsigned char*)d_ws; p.ph_lo = 0; p.ph_hi = 7;
  void* args[] = {&p};
  hipError_t e = hipLaunchCooperativeKernel((const void*)fwd_megakernel, dim3(grid_blocks), dim3(NTHREADS), args, LDS_BYTES, stream);
  if (e != hipSuccess) fprintf(stderr, "cooperative launch failed: %s (grid %d)\n", hipGetErrorString(e), grid_blocks);
}
```
